# Optimizing an MI355X kernel written in HIP

```python
import math
import jax
import jax.numpy as jnp
from jax import lax
import numpy as np


D_MODEL = 1024
BATCH = 2
SEQ = 16384
DEPTH = 2
DEC_BATCH = 8
DEC_SEQ = 2048
PAST_LEN = 128

HEAD_DIM = 64
GRID_W = 64
N_MEM = 256
LN_EPS = 1e-5
RMS_EPS = 1e-6
NEG_INF = -1e30

A_HEADS = 12
A_WIDTH = A_HEADS * HEAD_DIM
A_PATTERNS = ((128, 1), (512, 4), (2048, 16))
N_BUCKETS = 32
REL_MAX_DIST = 1024
FNET_GROUPS = 4
FNET_CH = 64
B_WIDTH = FNET_GROUPS * FNET_CH
C_Q_HEADS = 12
C_KV_HEADS = 4
C_WIDTH = C_Q_HEADS * HEAD_DIM
C_KV_WIDTH = C_KV_HEADS * HEAD_DIM
Q_BLOCK = 128
ROPE_THETA = 10000.0
POOL_WINDOWS = (2, 4, 8, 16)
POOL_CH = 64
D_WIDTH = len(POOL_WINDOWS) * POOL_CH
AB_IN = 3 * A_WIDTH + B_WIDTH
CD_IN = C_WIDTH + 2 * C_KV_WIDTH + D_WIDTH
AB_OUT = A_WIDTH + B_WIDTH
CD_OUT = C_WIDTH + D_WIDTH
XA_HEADS = 4
XA_HEAD_DIM = D_MODEL // XA_HEADS
FFN_HIDDEN = -(-8 * D_MODEL // (3 * 256)) * 256
DN_ALPHA = (2 * DEPTH) ** 0.25
DN_BETA = (8 * DEPTH) ** -0.25
N_EVEN = (DEPTH + 1) // 2
N_ODD = DEPTH // 2

kernel_name = 'hybrid_dilated_fourier_gqa_pool_encoder'


def layer_norm(x, g, b):
    xf = x.astype(jnp.float32)
    mu = xf.mean(-1, keepdims=True)
    var = jnp.square(xf - mu).mean(-1, keepdims=True)
    return ((xf - mu) * lax.rsqrt(var + LN_EPS) * g + b).astype(x.dtype)


def rms_norm(x, g):
    xf = x.astype(jnp.float32)
    return (xf * lax.rsqrt(jnp.square(xf).mean(-1, keepdims=True) + RMS_EPS) * g).astype(x.dtype)


def t5_bucket(rel):
    nb = N_BUCKETS // 2
    max_exact = nb // 2
    ret = jnp.where(rel > 0, nb, 0)
    n = jnp.abs(rel)
    nf = jnp.maximum(n, 1).astype(jnp.float32)
    large = max_exact + (jnp.log(nf / max_exact) / math.log(REL_MAX_DIST / max_exact)
                         * (nb - max_exact)).astype(jnp.int32)
    large = jnp.minimum(large, nb - 1)
    return ret + jnp.where(n < max_exact, n, large)


def dilated_window_attention(q, k, v, rel_bias, dilation, half):
    b, n, h, dh = q.shape
    L = n // dilation
    blk = half
    nblk = -(-L // blk)
    Lp = nblk * blk

    def to_strided(t):
        t = t.reshape(b, L, dilation, h, dh).transpose(0, 2, 1, 3, 4)
        return t.reshape(b * dilation, L, h, dh)

    def band(t):
        t = jnp.pad(t, ((0, 0), (blk, Lp - L + blk), (0, 0), (0, 0))).reshape(b * dilation, nblk + 2, blk, h, dh)
        return jnp.concatenate([t[:, :-2], t[:, 1:-1], t[:, 2:]], axis=2)

    qs = jnp.pad(to_strided(q), ((0, 0), (0, Lp - L), (0, 0), (0, 0))).reshape(b * dilation, nblk, blk, h, dh)
    kb = band(to_strided(k))
    vb = band(to_strided(v))

    off = jnp.arange(3 * blk)[None, :] - blk - jnp.arange(blk)[:, None]
    in_band = jnp.abs(off) <= half
    bias = rel_bias[t5_bucket(off * dilation)].transpose(2, 0, 1)
    key_u = jnp.arange(nblk)[:, None] * blk + jnp.arange(3 * blk)[None, :] - blk
    key_ok = (key_u >= 0) & (key_u < L)
    mask = in_band[None] & key_ok[:, None, :]

    logits = jnp.einsum('bnqhd,bnkhd->bnhqk', qs, kb, preferred_element_type=jnp.float32) * (HEAD_DIM ** -0.5)
    logits = logits + bias[None, None].astype(jnp.float32)
    logits = jnp.where(mask[None, :, None], logits, NEG_INF)
    lse = jax.nn.logsumexp(logits, axis=-1)
    p = jnp.exp(logits - lse[..., None]).astype(v.dtype)
    o = jnp.einsum('bnhqk,bnkhd->bnqhd', p, vb)
    o = o.reshape(b, dilation, Lp, h, dh)[:, :, :L].transpose(0, 2, 1, 3, 4).reshape(b, n, h, dh)
    lse = lse.transpose(0, 1, 3, 2).reshape(b, dilation, Lp, h)[:, :, :L].transpose(0, 2, 1, 3).reshape(b, n, h)
    return o, lse


def dilated_mixture(q, k, v, rel_bias):
    outs, lses = [], []
    for window, dilation in A_PATTERNS:
        o, lse = dilated_window_attention(q, k, v, rel_bias, dilation, window // (2 * dilation))
        outs.append(o)
        lses.append(lse)
    wts = jax.nn.softmax(jnp.stack(lses), axis=0).astype(q.dtype)
    return jnp.einsum('gbnh,gbnhd->bnhd', wts, jnp.stack(outs))


def fourier_mixer(u, g, w):
    uf = u.astype(jnp.float32)
    mu = uf.mean(-1, keepdims=True)
    var = jnp.square(uf - mu).mean(-1, keepdims=True)
    un = (uf - mu) * lax.rsqrt(var + LN_EPS) * g
    f = jnp.fft.fft2(un, axes=(1, 3), norm='ortho').real
    return jnp.einsum('bngc,gce->bnge', f.astype(u.dtype), w)


def axial_rope_tables(n):
    rows = n // GRID_W
    row_id = jnp.broadcast_to(jnp.arange(rows)[:, None], (rows, GRID_W)).reshape(n)
    col_id = jnp.broadcast_to(jnp.arange(GRID_W)[None, :], (rows, GRID_W)).reshape(n)
    axis_dim = HEAD_DIM // 2
    freqs = ROPE_THETA ** (-jnp.arange(0, axis_dim, 2, dtype=jnp.float32) / axis_dim)
    ang = jnp.concatenate([row_id[:, None] * freqs, col_id[:, None] * freqs], axis=-1)
    return jnp.cos(ang), jnp.sin(ang)


def apply_rope(x, cos, sin):
    xf = x.astype(jnp.float32).reshape(*x.shape[:-1], HEAD_DIM // 2, 2)
    c = cos[None, :, None]
    s = sin[None, :, None]
    x1, x2 = xf[..., 0], xf[..., 1]
    out = jnp.stack([x1 * c - x2 * s, x1 * s + x2 * c], axis=-1).reshape(x.shape)
    return out.astype(x.dtype)


def gqa_blocked(q, k, v):
    b, n, hq, dh = q.shape
    rep = hq // C_KV_HEADS
    nb = n // Q_BLOCK
    qb = q.reshape(b, nb, Q_BLOCK, C_KV_HEADS, rep, dh).transpose(1, 0, 2, 3, 4, 5)

    def one_block(qblk):
        s = jnp.einsum('bqgrd,bkgd->bgrqk', qblk, k, preferred_element_type=jnp.float32) * (HEAD_DIM ** -0.5)
        p = jax.nn.softmax(s, axis=-1).astype(v.dtype)
        return jnp.einsum('bgrqk,bkgd->bqgrd', p, v)

    o = lax.map(one_block, qb)
    return o.transpose(1, 0, 2, 3, 4, 5).reshape(b, n, hq, dh)


def multiscale_pool(u, w, scale):
    b, n = u.shape[0], u.shape[1]
    uf = u.astype(jnp.float32)
    csum = jnp.pad(jnp.cumsum(uf, axis=1), ((0, 0), (1, 0), (0, 0), (0, 0)))
    t = jnp.arange(n)
    pooled = []
    for gi, wdw in enumerate(POOL_WINDOWS):
        lo = jnp.clip(t - wdw // 2, 0, n)
        hi = jnp.clip(t + wdw // 2, 0, n)
        sg = csum[:, hi, gi] - csum[:, lo, gi]
        pooled.append(sg / (hi - lo).astype(jnp.float32)[None, :, None])
    mixed = (jnp.stack(pooled, axis=2) - uf).astype(u.dtype)
    y = jnp.einsum('bngc,gce->bnge', mixed, w)
    return y.reshape(b, n, D_WIDTH) * scale


def mixer_ab(x, rel_bias, w_in, fnet_g, fnet_w, w_out):
    b, n, _ = x.shape
    z = x @ w_in
    q, k, v, u = jnp.split(z, [A_WIDTH, 2 * A_WIDTH, 3 * A_WIDTH], axis=-1)
    q = q.reshape(b, n, A_HEADS, HEAD_DIM)
    k = k.reshape(b, n, A_HEADS, HEAD_DIM)
    v = v.reshape(b, n, A_HEADS, HEAD_DIM)
    o_a = dilated_mixture(q, k, v, rel_bias).reshape(b, n, A_WIDTH)
    o_b = fourier_mixer(u.reshape(b, n, FNET_GROUPS, FNET_CH), fnet_g, fnet_w).reshape(b, n, B_WIDTH)
    return jnp.concatenate([o_a, o_b], axis=-1) @ w_out


def mixer_cd(x, cos, sin, w_in, q_norm, k_norm, pool_w, pool_scale, w_out):
    b, n, _ = x.shape
    z = x @ w_in
    q, k, v, u = jnp.split(z, [C_WIDTH, C_WIDTH + C_KV_WIDTH, C_WIDTH + 2 * C_KV_WIDTH], axis=-1)
    q = apply_rope(rms_norm(q.reshape(b, n, C_Q_HEADS, HEAD_DIM), q_norm), cos, sin)
    k = apply_rope(rms_norm(k.reshape(b, n, C_KV_HEADS, HEAD_DIM), k_norm), cos, sin)
    v = v.reshape(b, n, C_KV_HEADS, HEAD_DIM)
    o_c = gqa_blocked(q, k, v).reshape(b, n, C_WIDTH)
    o_d = multiscale_pool(u.reshape(b, n, len(POOL_WINDOWS), POOL_CH), pool_w, pool_scale)
    return jnp.concatenate([o_c, o_d], axis=-1) @ w_out


def memory_cross_attention(x, mem, w_q, w_kv, w_o):
    b, n, _ = x.shape
    m = mem.shape[1]
    q = (x @ w_q).reshape(b, n, XA_HEADS, XA_HEAD_DIM)
    kv = (mem @ w_kv).reshape(b, m, 2, XA_HEADS, XA_HEAD_DIM)
    s = jnp.einsum('bnhd,bmhd->bhnm', q, kv[:, :, 0], preferred_element_type=jnp.float32) * (XA_HEAD_DIM ** -0.5)
    p = jax.nn.softmax(s, axis=-1).astype(x.dtype)
    o = jnp.einsum('bhnm,bmhd->bnhd', p, kv[:, :, 1]).reshape(b, n, D_MODEL)
    return o @ w_o


def swiglu(x, w_in, w_out):
    g, u = jnp.split(x @ w_in, 2, axis=-1)
    return (jax.nn.silu(g) * u) @ w_out


def run_trunk(x, mem, rel_bias, ab_w_in, ab_fnet_g, ab_fnet_w, ab_w_out,
              cd_w_in, cd_q_norm, cd_k_norm, cd_pool_w, cd_pool_scale, cd_w_out,
              xa_w_q, xa_w_kv, xa_w_o, ffn_w_in, ffn_w_out, ln_g, ln_b):
    n = x.shape[1]
    cos, sin = axial_rope_tables(n)
    for layer in range(DEPTH):
        i = layer // 2
        if layer % 2 == 0:
            h = mixer_ab(x, rel_bias, ab_w_in[i], ab_fnet_g[i], ab_fnet_w[i], ab_w_out[i])
        else:
            h = mixer_cd(x, cos, sin, cd_w_in[i], cd_q_norm[i], cd_k_norm[i],
                         cd_pool_w[i], cd_pool_scale[i], cd_w_out[i])
        x = layer_norm(DN_ALPHA * x + h, ln_g[layer, 0], ln_b[layer, 0])
        h = memory_cross_attention(x, mem, xa_w_q[layer], xa_w_kv[layer], xa_w_o[layer])
        x = layer_norm(DN_ALPHA * x + h, ln_g[layer, 1], ln_b[layer, 1])
        h = swiglu(x, ffn_w_in[layer], ffn_w_out[layer])
        x = layer_norm(DN_ALPHA * x + h, ln_g[layer, 2], ln_b[layer, 2])
    return x


def setup_inputs(seed: int = 0) -> dict:
    key = jax.random.key(seed)
    ks = jax.random.split(key, 22)
    D = D_MODEL

    def nrm(k, shape, s):
        return jax.random.normal(k, shape, jnp.float32) * s

    return {
        'x_prompt': nrm(ks[0], (BATCH, SEQ, D), 1.0),
        'x_sample': nrm(ks[1], (DEC_BATCH, DEC_SEQ, D), 1.0),
        'mem_prompt': nrm(ks[2], (BATCH, N_MEM, D), 1.0),
        'mem_sample': nrm(ks[3], (DEC_BATCH, N_MEM, D), 1.0),
        'rel_bias': nrm(ks[4], (N_BUCKETS, A_HEADS), 0.2),
        'ab_w_in': nrm(ks[5], (N_EVEN, D, AB_IN), D ** -0.5),
        'ab_fnet_g': 1.0 + nrm(ks[6], (N_EVEN, FNET_GROUPS, FNET_CH), 0.02),
        'ab_fnet_w': nrm(ks[7], (N_EVEN, FNET_GROUPS, FNET_CH, FNET_CH), FNET_CH ** -0.5),
        'ab_w_out': nrm(ks[8], (N_EVEN, AB_OUT, D), AB_OUT ** -0.5 * DN_BETA),
        'cd_w_in': nrm(ks[9], (N_ODD, D, CD_IN), D ** -0.5),
        'cd_q_norm': 1.0 + nrm(ks[10], (N_ODD, HEAD_DIM), 0.02),
        'cd_k_norm': 1.0 + nrm(ks[11], (N_ODD, HEAD_DIM), 0.02),
        'cd_pool_w': nrm(ks[12], (N_ODD, len(POOL_WINDOWS), POOL_CH, POOL_CH), POOL_CH ** -0.5),
        'cd_pool_scale': 1.0 + nrm(ks[13], (N_ODD, D_WIDTH), 0.02),
        'cd_w_out': nrm(ks[14], (N_ODD, CD_OUT, D), CD_OUT ** -0.5 * DN_BETA),
        'xa_w_q': nrm(ks[15], (DEPTH, D, D), D ** -0.5),
        'xa_w_kv': nrm(ks[16], (DEPTH, D, 2 * D), D ** -0.5),
        'xa_w_o': nrm(ks[17], (DEPTH, D, D), D ** -0.5 * DN_BETA),
        'ffn_w_in': nrm(ks[18], (DEPTH, D, 2 * FFN_HIDDEN), D ** -0.5),
        'ffn_w_out': nrm(ks[19], (DEPTH, FFN_HIDDEN, D), FFN_HIDDEN ** -0.5 * DN_BETA),
        'ln_g': 1.0 + nrm(ks[20], (DEPTH, 3, D), 0.02),
        'ln_b': nrm(ks[21], (DEPTH, 3, D), 0.02),
    }


def reference(x_prompt, x_sample, mem_prompt, mem_sample, rel_bias, ab_w_in, ab_fnet_g, ab_fnet_w, ab_w_out,
              cd_w_in, cd_q_norm, cd_k_norm, cd_pool_w, cd_pool_scale, cd_w_out,
              xa_w_q, xa_w_kv, xa_w_o, ffn_w_in, ffn_w_out, ln_g, ln_b):
    y_prompt = run_trunk(x_prompt, mem_prompt, rel_bias, ab_w_in, ab_fnet_g, ab_fnet_w, ab_w_out,
                         cd_w_in, cd_q_norm, cd_k_norm, cd_pool_w, cd_pool_scale, cd_w_out,
                         xa_w_q, xa_w_kv, xa_w_o, ffn_w_in, ffn_w_out, ln_g, ln_b)
    y_sample = run_trunk(x_sample, mem_sample, rel_bias, ab_w_in, ab_fnet_g, ab_fnet_w, ab_w_out,
                         cd_w_in, cd_q_norm, cd_k_norm, cd_pool_w, cd_pool_scale, cd_w_out,
                         xa_w_q, xa_w_kv, xa_w_o, ffn_w_in, ffn_w_out, ln_g, ln_b)
    return (y_prompt, y_sample)
```

```cpp
#include <hip/hip_runtime.h>
#include <hip/hip_bf16.h>
#include <hip/hip_cooperative_groups.h>
#include <cstdio>
#include <cstdint>
#include <cmath>
namespace cg = cooperative_groups;

namespace pg8 {
#define PG8_LAS __attribute__((address_space(3)))
typedef unsigned short bf16_t;
typedef short bf16x8 __attribute__((ext_vector_type(8)));
typedef float f32x4 __attribute__((ext_vector_type(4)));
typedef unsigned u32x4 __attribute__((ext_vector_type(4)));
constexpr int BM = 256, BK = 64, HALF = 128, HTB = HALF * BK * 2, STAGE_BYTES = 8 * HTB, NXCD = 8, WGM = 8;
__device__ __forceinline__ int lds_byte(int r, int c) { const int st = (r >> 4) * 2 + (c >> 5), rr = r & 15, cc = c & 31, ob = rr * 64 + cc * 2; return st * 1024 + (ob ^ (((ob >> 9) & 1) << 5)); }
__device__ __forceinline__ void stage_rc(int b, int& R, int& C) { const int st = b / 1024, sb = b % 1024, swz = sb ^ (((sb >> 9) & 1) << 5); R = (st >> 1) * 16 + swz / 64; C = (st & 1) * 32 + (swz % 64) / 2; }
__device__ __forceinline__ int perm32(int rho) { const int n = rho >> 4, i = rho & 15; return 8 * (i >> 2) + 4 * n + (i & 3); }

struct Unit { const char* a; const char* b; int pm, pn, bt; };
struct Gemm { int K; unsigned lda, ldb, hstepA, hstepB; };
struct GD {
    int kind, K; unsigned lda, ldb, hA, hB;
    int nM, nN, nb, bdiv; const char *A, *B; unsigned tA, tB, aHi, aLo, bHi, bLo;
    bf16_t* O; unsigned cs_hi, cs_lo, obdiv, pm_stride, ldc, pn_stride, bj_stride; int nscale; float scale0; int rows_valid;
    const float *r0, *r1; float* out; int split, row0, rpb, pad;
};
typedef const __attribute__((address_space(4))) GD* cgd_t;
struct GenSched {
    cgd_t d; int G, c;
    __device__ __forceinline__ bool next(int i, Unit& u) const {
        const int nM = d->nM, nN = d->nN;
        const long L = (long)i * G + c; const int per = nM * nN; if (L >= (long)per * d->nb) return false;
        const int bt = (int)(L / per); int wgid = (int)(L % per);
        { const int q = per / NXCD, r = per % NXCD, xcd = wgid % NXCD, off = wgid / NXCD; wgid = (xcd < r ? xcd * (q + 1) : r * (q + 1) + (xcd - r) * q) + off; }
        const int nig = WGM * nN, gid = wgid / nig, fm = gid * WGM, gsz = (nM - fm) < WGM ? (nM - fm) : WGM;
        u.pm = fm + ((wgid % nig) % gsz); u.pn = (wgid % nig) / gsz; u.bt = bt;
        const int bdiv = d->bdiv, bh = bt / bdiv, bl = bt % bdiv;
        u.a = d->A + (size_t)bh * d->aHi + (size_t)bl * d->aLo + (size_t)u.pm * d->tA; u.b = d->B + (size_t)bh * d->bHi + (size_t)bl * d->bLo + (size_t)u.pn * d->tB; return true;
    }
    __device__ __forceinline__ void a_ready(const Unit&) const {}
    __device__ __forceinline__ void done(const Unit&) const {}
};

__device__ __forceinline__ unsigned cvt_pk_bf16(float lo, float hi) { unsigned r; asm volatile("v_cvt_pk_bf16_f32 %0, %1, %2" : "=v"(r) : "v"(lo), "v"(hi)); return r; }
__device__ __forceinline__ size_t tile_off(cgd_t o, const Unit& u) { const unsigned bd = o->obdiv; return (size_t)(u.bt / bd) * o->cs_hi + (size_t)(u.bt % bd) * o->cs_lo + (size_t)u.pm * o->pm_stride + (size_t)u.pn * o->pn_stride; }
#define PG8_EPI_ARGS const Unit& u, int wr, int wc, int fr, int fq, PG8_LAS unsigned char* xlds, int wid, int lane

struct EpiBf16 {
    static constexpr bool PERM = true, AFTER_DRAIN = false;
    cgd_t d;
    __device__ __forceinline__ void operator()(f32x4 (&acc)[2][2][4][2], PG8_EPI_ARGS) const {
        const size_t ldc = d->ldc, bjs = d->bj_stride; const int rows_valid = d->rows_valid;
        bf16_t* base = d->O + tile_off(d, u) + (size_t)(wr * 64 + fr) * ldc + wc * 32 + 8 * fq;
        const float sc = (u.pn < d->nscale) ? d->scale0 : 1.f;
#pragma unroll
        for (int ai = 0; ai < 2; ++ai) { if (ai * HALF >= rows_valid) continue;
#pragma unroll
            for (int m = 0; m < 4; ++m) { bf16_t* rowp = base + (size_t)(ai * HALF + m * 16) * ldc;
#pragma unroll
                for (int bj = 0; bj < 2; ++bj) { const f32x4 v0 = acc[ai][bj][m][0] * sc, v1 = acc[ai][bj][m][1] * sc;
                    u32x4 w; w.x = cvt_pk_bf16(v0[0], v0[1]); w.y = cvt_pk_bf16(v0[2], v0[3]); w.z = cvt_pk_bf16(v1[0], v1[1]); w.w = cvt_pk_bf16(v1[2], v1[3]);
                    *(u32x4*)(rowp + bj * bjs) = w; } } }
    }
};
struct EpiSwiglu {
    static constexpr bool PERM = true, AFTER_DRAIN = false;
    cgd_t d;
    __device__ __forceinline__ void operator()(f32x4 (&acc)[2][2][4][2], PG8_EPI_ARGS) const {
        const size_t ldc = d->ldc; bf16_t* base = d->O + (size_t)(u.pm * BM + wr * 64 + fr) * ldc + u.pn * HALF + wc * 32 + 8 * fq;
#pragma unroll
        for (int ai = 0; ai < 2; ++ai)
#pragma unroll
            for (int m = 0; m < 4; ++m) { float o[8];
#pragma unroll
                for (int n = 0; n < 2; ++n)
#pragma unroll
                    for (int j = 0; j < 4; ++j) { const float g = acc[ai][0][m][n][j], up = acc[ai][1][m][n][j];
                        o[n * 4 + j] = g * __builtin_amdgcn_rcpf(1.f + __builtin_amdgcn_exp2f(-1.4426950408889634f * g)) * up; }
                u32x4 w; w.x = cvt_pk_bf16(o[0], o[1]); w.y = cvt_pk_bf16(o[2], o[3]); w.z = cvt_pk_bf16(o[4], o[5]); w.w = cvt_pk_bf16(o[6], o[7]);
                *(u32x4*)(base + (size_t)(ai * HALF + m * 16) * ldc) = w; }
    }
};
struct EpiResid {
    static constexpr bool PERM = false, AFTER_DRAIN = false;
    cgd_t d; float alpha;
    __device__ __forceinline__ void operator()(f32x4 (&acc)[2][2][4][2], PG8_EPI_ARGS) const {
        const float* r0 = d->r0; const float* r1 = d->r1; float* out = d->out; const int split = d->split;
        const int rbase = d->row0 + u.bt * d->rpb + u.pm * BM + wr * 64 + fr, col0 = u.pn * BM + wc * 32 + 4 * fq;
#pragma unroll
        for (int ai = 0; ai < 2; ++ai)
#pragma unroll
            for (int m = 0; m < 4; ++m) { const int row = rbase + ai * HALF + m * 16;
                const float* rp = (row < split ? r0 + (size_t)row * 1024 : r1 + (size_t)(row - split) * 1024) + col0; float* op = out + (size_t)row * 1024 + col0;
#pragma unroll
                for (int bj = 0; bj < 2; ++bj)
#pragma unroll
                    for (int n = 0; n < 2; ++n) { const f32x4 b = *(const f32x4*)(rp + bj * HALF + n * 16); *(f32x4*)(op + bj * HALF + n * 16) = b * alpha + acc[ai][bj][m][n]; } }
    }
};
struct EpiSoftmax {
    static constexpr bool PERM = true, AFTER_DRAIN = false;
    cgd_t d;
    __device__ __forceinline__ void operator()(f32x4 (&acc)[2][2][4][2], PG8_EPI_ARGS) const {
        PG8_LAS float* PM = (PG8_LAS float*)xlds; PG8_LAS float* PS = (PG8_LAS float*)(xlds + 4096);
#pragma unroll
        for (int ai = 0; ai < 2; ++ai)
#pragma unroll
            for (int m = 0; m < 4; ++m) { float mx = -INFINITY;
#pragma unroll
                for (int bj = 0; bj < 2; ++bj)
#pragma unroll
                    for (int n = 0; n < 2; ++n) { const f32x4 x = acc[ai][bj][m][n]; mx = fmaxf(fmaxf(mx, fmaxf(x[0], x[1])), fmaxf(x[2], x[3])); }
                mx = fmaxf(mx, __shfl_xor(mx, 16)); mx = fmaxf(mx, __shfl_xor(mx, 32));
                if (fq == 0) PM[(ai * HALF + wr * 64 + m * 16 + fr) * 4 + wc] = mx; }
        asm volatile("s_waitcnt lgkmcnt(0)" ::: "memory"); __builtin_amdgcn_s_barrier(); asm volatile("" ::: "memory");
#pragma unroll
        for (int ai = 0; ai < 2; ++ai)
#pragma unroll
            for (int m = 0; m < 4; ++m) { const int row = ai * HALF + wr * 64 + m * 16 + fr; const f32x4 p4 = *(const PG8_LAS f32x4*)(PM + row * 4);
                const float gm = fmaxf(fmaxf(p4[0], p4[1]), fmaxf(p4[2], p4[3])); float s = 0.f;
#pragma unroll
                for (int bj = 0; bj < 2; ++bj)
#pragma unroll
                    for (int n = 0; n < 2; ++n) { f32x4 x = acc[ai][bj][m][n];
#pragma unroll
                        for (int j = 0; j < 4; ++j) { x[j] = __builtin_amdgcn_exp2f(x[j] - gm); s += x[j]; }
                        acc[ai][bj][m][n] = x; }
                s += __shfl_xor(s, 16); s += __shfl_xor(s, 32);
                if (fq == 0) PS[row * 4 + wc] = s; }
        asm volatile("s_waitcnt lgkmcnt(0)" ::: "memory"); __builtin_amdgcn_s_barrier(); asm volatile("" ::: "memory");
        const size_t ldc = d->ldc, bjs = d->bj_stride; bf16_t* base = d->O + tile_off(d, u) + (size_t)(wr * 64 + fr) * ldc + wc * 32 + 8 * fq;
#pragma unroll
        for (int ai = 0; ai < 2; ++ai)
#pragma unroll
            for (int m = 0; m < 4; ++m) { const int row = ai * HALF + wr * 64 + m * 16 + fr; const f32x4 s4 = *(const PG8_LAS f32x4*)(PS + row * 4);
                const float inv = 1.f / ((s4[0] + s4[1]) + (s4[2] + s4[3])); bf16_t* rowp = base + (size_t)(ai * HALF + m * 16) * ldc;
#pragma unroll
                for (int bj = 0; bj < 2; ++bj) { const f32x4 v0 = acc[ai][bj][m][0] * inv, v1 = acc[ai][bj][m][1] * inv;
                    u32x4 w; w.x = cvt_pk_bf16(v0[0], v0[1]); w.y = cvt_pk_bf16(v0[2], v0[3]); w.z = cvt_pk_bf16(v1[0], v1[1]); w.w = cvt_pk_bf16(v1[2], v1[3]);
                    *(u32x4*)(rowp + bj * bjs) = w; } }
    }
};
struct EpiTwiddle {
    static constexpr bool PERM = true, AFTER_DRAIN = false;
    cgd_t d;
    __device__ __forceinline__ void operator()(f32x4 (&acc)[2][2][4][2], PG8_EPI_ARGS) const {
        bf16_t* O = d->O;
#pragma unroll
        for (int m = 0; m < 4; ++m) { const int k1 = wr * 64 + m * 16 + fr;
#pragma unroll
            for (int bj = 0; bj < 2; ++bj) { float re[8], im[8]; int k1o = k1; asm volatile("" : "+v"(k1o));
#pragma unroll
                for (int n = 0; n < 2; ++n)
#pragma unroll
                    for (int j = 0; j < 4; ++j) { const int n2 = wc * 32 + 8 * fq + 4 * n + j; const float rev = (float)((k1o * n2) & 16383) * (1.0f / 16384.0f);
                        const float tc = __builtin_amdgcn_cosf(rev), ts = __builtin_amdgcn_sinf(rev); const float a = acc[0][bj][m][n][j], b = acc[1][bj][m][n][j];
                        re[n * 4 + j] = a * tc + b * ts; im[n * 4 + j] = b * tc - a * ts; }
                bf16_t* p = O + ((size_t)(2 * u.bt + bj) * 128 + k1) * 256 + wc * 32 + 8 * fq;
                u32x4 w; w.x = cvt_pk_bf16(re[0], re[1]); w.y = cvt_pk_bf16(re[2], re[3]); w.z = cvt_pk_bf16(re[4], re[5]); w.w = cvt_pk_bf16(re[6], re[7]); *(u32x4*)p = w;
                w.x = cvt_pk_bf16(im[0], im[1]); w.y = cvt_pk_bf16(im[2], im[3]); w.z = cvt_pk_bf16(im[4], im[5]); w.w = cvt_pk_bf16(im[6], im[7]); *(u32x4*)(p + 128) = w; } }
    }
};
template <class Epi, class Sched, bool ALIGN_EPI = false, bool SP2 = false>
__device__ __forceinline__ void gemm_phase(PG8_LAS unsigned char* lds, PG8_LAS unsigned char* xlds, const Gemm g, const Sched& S, const Epi& E) {
    int tid_l = threadIdx.x; asm volatile("" : "+v"(tid_l));
    const int tid = tid_l, wid = __builtin_amdgcn_readfirstlane(tid >> 6), lane = tid & 63, wr = wid >> 2, wc = wid & 3, fr = lane & 15, fq = lane >> 4;
    const int K = g.K, nt = K / BK;
    unsigned voffA[2], voffB[2];
#pragma unroll
    for (int i = 0; i < 2; ++i) { int R, C; stage_rc(tid * 16 + i * 8192, R, C); const int Rb = Epi::PERM ? ((R & ~31) + perm32(R & 31)) : R;
        voffA[i] = (unsigned)(R * g.lda + C) * 2u; voffB[i] = (unsigned)(Rb * g.ldb + C) * 2u; }
    const size_t kstep = (size_t)(BK * 2);
    const unsigned hstepA = g.hstepA, hstepB = g.hstepB;
    const unsigned ldsw = (unsigned)wid * 1024u;
    const int aoff = lds_byte(wr * 64 + fr, fq * 8), boff = lds_byte(wc * 32 + fr, fq * 8);
#define PG8_SA(b, h) (((b) * 2 + (h)) * HTB)
#define PG8_SB(b, h) ((4 + (b) * 2 + (h)) * HTB)
#define PG8_STAGE(bufoff, gbase, voff) do { _Pragma("unroll") for (int _i = 0; _i < 2; ++_i) \
        __builtin_amdgcn_global_load_lds((const unsigned*)((const char*)(gbase) + (voff)[_i]), (PG8_LAS unsigned*)(lds + (bufoff) + ldsw + _i * 8192), 16, 0, 0); } while (0)
#define PG8_LDA(dst, b, h) do { _Pragma("unroll") for (int m = 0; m < 4; ++m) _Pragma("unroll") for (int k = 0; k < 2; ++k) dst[m][k] = *(const PG8_LAS bf16x8*)(lds + PG8_SA(b, h) + aoff + m * 2048 + k * 1024); } while (0)
#define PG8_LDB(dst, b, h) do { _Pragma("unroll") for (int n = 0; n < 2; ++n) _Pragma("unroll") for (int k = 0; k < 2; ++k) dst[n][k] = *(const PG8_LAS bf16x8*)(lds + PG8_SB(b, h) + boff + n * 2048 + k * 1024); } while (0)
#define PG8_MMA(ai, bj, At, Bt) do { __builtin_amdgcn_s_setprio(1); _Pragma("unroll") for (int m = 0; m < 4; ++m) _Pragma("unroll") for (int n = 0; n < 2; ++n) _Pragma("unroll") for (int k = 0; k < 2; ++k) \
        acc[ai][bj][m][n] = __builtin_amdgcn_mfma_f32_16x16x32_bf16(Bt[n][k], At[m][k], acc[ai][bj][m][n], 0, 0, 0); __builtin_amdgcn_s_setprio(0); } while (0)
#define PG8_WAIT_V(n) asm volatile("s_waitcnt vmcnt(" #n ")" ::: "memory")
#define PG8_WAIT_L(n) asm volatile("s_waitcnt lgkmcnt(" #n ")" ::: "memory")
#define PG8_BAR __builtin_amdgcn_s_barrier()
#define PG8_SCHED __builtin_amdgcn_sched_barrier(0)
    Unit cur, nxt; int ui = 0;
    if (!S.next(0, cur)) return;
    f32x4 acc[2][2][4][2];
#pragma unroll
    for (int a = 0; a < 2; ++a)
#pragma unroll
        for (int b = 0; b < 2; ++b)
#pragma unroll
            for (int m = 0; m < 4; ++m)
#pragma unroll
                for (int n = 0; n < 2; ++n) acc[a][b][m][n] = (f32x4){0.f, 0.f, 0.f, 0.f};
    bf16x8 At[4][2], B0[2][2], B1[2][2];
    const char* cA = cur.a; const char* cB = cur.b;
    S.a_ready(cur);
    if constexpr (SP2) {
        PG8_STAGE(PG8_SB(0, 0), cB, voffB); PG8_STAGE(PG8_SB(0, 1), cB + hstepB, voffB); PG8_STAGE(PG8_SA(0, 0), cA, voffA); PG8_STAGE(PG8_SA(0, 1), cA + hstepA, voffA);
        if (wr == 1) PG8_BAR;
        PG8_WAIT_V(2); PG8_BAR;
        PG8_STAGE(PG8_SB(1, 0), cB + kstep, voffB); PG8_STAGE(PG8_SA(1, 0), cA + kstep, voffA); PG8_STAGE(PG8_SB(1, 1), cB + hstepB + kstep, voffB);
        PG8_WAIT_V(6); PG8_BAR;
    } else {
        PG8_STAGE(PG8_SB(0, 0), cB, voffB); PG8_STAGE(PG8_SA(0, 0), cA, voffA); PG8_STAGE(PG8_SB(0, 1), cB + hstepB, voffB); PG8_STAGE(PG8_SA(0, 1), cA + hstepA, voffA);
        if (wr == 1) PG8_BAR;
        PG8_WAIT_V(4); PG8_BAR;
        PG8_STAGE(PG8_SB(1, 0), cB + kstep, voffB); PG8_STAGE(PG8_SA(1, 0), cA + kstep, voffA); PG8_STAGE(PG8_SB(1, 1), cB + hstepB + kstep, voffB);
        PG8_WAIT_V(6); PG8_BAR;
    }
    for (;;) {
        const bool has_next = S.next(ui + 1, nxt);
        const char* nA = has_next ? nxt.a : cA; const char* nB = has_next ? nxt.b : cB;
        for (int t = 0; t < nt; t += 2) {
            const bool last = (t == nt - 2);
            const char* a1 = cA + (size_t)(t + 1) * kstep;
            const char* a2 = last ? nA : cA + (size_t)(t + 2) * kstep; const char* b2 = last ? nB : cB + (size_t)(t + 2) * kstep;
            const char* a3 = a2 + kstep; const char* b3 = b2 + kstep;
            if (last && has_next) S.a_ready(nxt);
            if constexpr (SP2) {
            PG8_LDB(B0, 0, 0); PG8_LDB(B1, 0, 1); PG8_SCHED; PG8_LDA(At, 0, 0); PG8_STAGE(PG8_SA(1, 1), a1 + hstepA, voffA);
            PG8_WAIT_V(8); PG8_WAIT_L(0); PG8_BAR; PG8_MMA(0, 0, At, B0); PG8_MMA(0, 1, At, B1); PG8_BAR; PG8_SCHED;
            PG8_LDA(At, 0, 1); PG8_STAGE(PG8_SB(0, 0), b2, voffB); PG8_STAGE(PG8_SB(0, 1), b2 + hstepB, voffB); PG8_STAGE(PG8_SA(0, 0), a2, voffA);
            PG8_WAIT_V(8); PG8_WAIT_L(0); PG8_BAR; PG8_MMA(1, 0, At, B0); PG8_MMA(1, 1, At, B1); PG8_BAR; PG8_SCHED;
            PG8_LDB(B0, 1, 0); PG8_LDB(B1, 1, 1); PG8_SCHED; PG8_LDA(At, 1, 0); PG8_STAGE(PG8_SA(0, 1), a2 + hstepA, voffA);
            PG8_WAIT_V(8); PG8_WAIT_L(0); PG8_BAR; PG8_MMA(0, 0, At, B0); PG8_MMA(0, 1, At, B1); PG8_BAR; PG8_SCHED;
            PG8_LDA(At, 1, 1); PG8_STAGE(PG8_SB(1, 0), b3, voffB); PG8_STAGE(PG8_SB(1, 1), b3 + hstepB, voffB); PG8_STAGE(PG8_SA(1, 0), a3, voffA);
            PG8_WAIT_V(8); PG8_WAIT_L(0); PG8_BAR; PG8_MMA(1, 0, At, B0); PG8_MMA(1, 1, At, B1); PG8_BAR; PG8_SCHED;
            } else {
            PG8_LDB(B0, 0, 0); PG8_SCHED; PG8_LDA(At, 0, 0); PG8_STAGE(PG8_SA(1, 1), a1 + hstepA, voffA);
            PG8_WAIT_L(8); PG8_BAR; PG8_WAIT_L(0); PG8_MMA(0, 0, At, B0); PG8_BAR; PG8_SCHED;
            PG8_LDB(B1, 0, 1); PG8_STAGE(PG8_SB(0, 0), b2, voffB);
            PG8_BAR; PG8_WAIT_L(0); PG8_MMA(0, 1, At, B1); PG8_BAR;
            PG8_LDA(At, 0, 1); PG8_STAGE(PG8_SA(0, 0), a2, voffA);
            PG8_BAR; PG8_WAIT_L(0); PG8_MMA(1, 0, At, B0); PG8_BAR; PG8_SCHED;
            PG8_STAGE(PG8_SB(0, 1), b2 + hstepB, voffB);
            PG8_WAIT_V(6); PG8_BAR; PG8_MMA(1, 1, At, B1); PG8_BAR;
            PG8_LDB(B0, 1, 0); PG8_SCHED; PG8_LDA(At, 1, 0); PG8_STAGE(PG8_SA(0, 1), a2 + hstepA, voffA);
            PG8_WAIT_L(8); PG8_BAR; PG8_WAIT_L(0); PG8_MMA(0, 0, At, B0); PG8_BAR; PG8_SCHED;
            PG8_LDB(B1, 1, 1); PG8_STAGE(PG8_SB(1, 0), b3, voffB);
            PG8_BAR; PG8_WAIT_L(0); PG8_MMA(0, 1, At, B1); PG8_BAR;
            PG8_LDA(At, 1, 1); PG8_STAGE(PG8_SA(1, 0), a3, voffA);
            PG8_BAR; PG8_WAIT_L(0); PG8_MMA(1, 0, At, B0); PG8_BAR; PG8_SCHED;
            PG8_STAGE(PG8_SB(1, 1), b3 + hstepB, voffB);
            PG8_WAIT_V(6); PG8_BAR; PG8_MMA(1, 1, At, B1); PG8_BAR;
            }
        }
        if constexpr (ALIGN_EPI) { if (wr == 0) PG8_BAR; }
        if constexpr (!Epi::AFTER_DRAIN) { E(acc, cur, wr, wc, fr, fq, xlds, wid, lane); S.done(cur); }
        if (!has_next) break;
#pragma unroll
        for (int a = 0; a < 2; ++a)
#pragma unroll
            for (int b = 0; b < 2; ++b)
#pragma unroll
                for (int m = 0; m < 4; ++m)
#pragma unroll
                    for (int n = 0; n < 2; ++n) acc[a][b][m][n] = (f32x4){0.f, 0.f, 0.f, 0.f};
        cur = nxt; cA = nA; cB = nB; ++ui;
        if constexpr (ALIGN_EPI) { if (wr == 1) PG8_BAR; }
    }
    PG8_WAIT_V(0);
    if constexpr (!ALIGN_EPI) { if (wr == 0) PG8_BAR; }
    PG8_BAR;
    if constexpr (Epi::AFTER_DRAIN) { E.fused(acc, cur, wr, wc, fr, fq, lds, wid, lane); S.done(cur); }
#undef PG8_SA
#undef PG8_SB
#undef PG8_STAGE
#undef PG8_LDA
#undef PG8_LDB
#undef PG8_MMA
#undef PG8_WAIT_V
#undef PG8_WAIT_L
#undef PG8_BAR
#undef PG8_SCHED
}
}
#include <hip/hip_bf16.h>
#include <cmath>
namespace attn_body {
using bf16=__hip_bfloat16;
using bf16x8=__attribute__((ext_vector_type(8)))short;
using s16x4=__attribute__((ext_vector_type(4)))short;
using f32x16=__attribute__((ext_vector_type(16)))float;
using u32x4=__attribute__((ext_vector_type(4)))unsigned;
constexpr int D=64,DM=1536;
constexpr int NW=8,QBLK=32,QB=QBLK*NW,KVBLK=64;
constexpr int ATTN_PITCH=DM, ATTN_UNIT_ROWS=QB;
__device__ __forceinline__ int crow(int r,int hi){return (r&3)+8*(r>>2)+4*hi;}
#define SBAR() __builtin_amdgcn_sched_barrier(0)
__device__ __forceinline__ void cmask(f32x16&p0,f32x16&p1,int jb,int qrel,int hi){
  const float NEG=-INFINITY; int kb=64*jb+4*hi;
  #pragma unroll
  for(int r=0;r<16;++r){int kv=kb+(r&3)+8*(r>>2); if(kv>qrel)p0[r]=NEG; if(kv+32>qrel)p1[r]=NEG;}
}

constexpr int NSLOT=3, SLOTB=8192;
constexpr int LDS_K=0, LDS_V=NSLOT*SLOTB, LDS_WS=2*NSLOT*SLOTB, LDS_OST=LDS_WS+NW*64*4, LDS_BYTES=LDS_OST+NW*4096;
constexpr float C2=0.125f*1.4426950408889634f;
__device__ __forceinline__ void glds16(const void*gsrc,unsigned lds_dst){unsigned keep;
  asm volatile("s_mov_b32 %0, m0\n\ts_mov_b32 m0, %2\n\ts_nop 0\n\tglobal_load_lds_dwordx4 %1, off\n\ts_mov_b32 m0, %0":"=&s"(keep):"v"(gsrc),"s"(lds_dst):"memory");}
__device__ __forceinline__ float max3f(float a,float b,float c){float r;asm("v_max3_f32 %0, %1, %2, %3":"=v"(r):"v"(a),"v"(b),"v"(c));return r;}
__device__ __forceinline__ float max2f(float a,float b){float r;asm("v_max_f32_e32 %0, %1, %2":"=v"(r):"v"(a),"v"(b));return r;}
__device__ __forceinline__ float fadd_s(float a,float b){float r;asm("v_add_f32_e32 %0, %1, %2":"=v"(r):"v"(a),"v"(b));return r;}
__device__ __forceinline__ float fsub_s(float a,float b){float r;asm("v_sub_f32_e32 %0, %1, %2":"=v"(r):"v"(a),"v"(b));return r;}
typedef float f32x2_t __attribute__((ext_vector_type(2))); typedef __bf16 bf16x2_t __attribute__((ext_vector_type(2)));
__device__ __forceinline__ unsigned cvtpk_s(float lo,float hi){f32x2_t v={lo,hi};bf16x2_t b=__builtin_convertvector(v,bf16x2_t);return __builtin_bit_cast(unsigned,b);}
#define WAIT_BAR(N) asm volatile("s_waitcnt vmcnt(" #N ") lgkmcnt(0)\n\ts_barrier":::"memory")

__device__ __forceinline__ void qkt(f32x16&p0,f32x16&p1,const char*Kslot,const bf16x8*qr,const f32x16&negm,int r32,int hi){
  const char*kb=Kslot+hi*1024+r32*16;
  #pragma unroll
  for(int d0=0;d0<4;++d0){
    const bf16x8 b0=*reinterpret_cast<const bf16x8*>(kb+d0*2048);
    const bf16x8 b1=*reinterpret_cast<const bf16x8*>(kb+d0*2048+512);
    if(d0==0){p0=__builtin_amdgcn_mfma_f32_32x32x16_bf16(b0,qr[0],negm,0,0,0);p1=__builtin_amdgcn_mfma_f32_32x32x16_bf16(b1,qr[0],negm,0,0,0);}
    else{p0=__builtin_amdgcn_mfma_f32_32x32x16_bf16(b0,qr[d0],p0,0,0,0);p1=__builtin_amdgcn_mfma_f32_32x32x16_bf16(b1,qr[d0],p1,0,0,0);}}
}
typedef __attribute__((address_space(3))) const char* lds_cptr;
typedef short v4i16_t __attribute__((ext_vector_type(4)));
__device__ __forceinline__ void kload8(bf16x8*kf,lds_cptr kp){
  kf[0]=*(const __attribute__((address_space(3))) bf16x8*)(kp);      kf[1]=*(const __attribute__((address_space(3))) bf16x8*)(kp+512);
  kf[2]=*(const __attribute__((address_space(3))) bf16x8*)(kp+2048); kf[3]=*(const __attribute__((address_space(3))) bf16x8*)(kp+2560);
  kf[4]=*(const __attribute__((address_space(3))) bf16x8*)(kp+4096); kf[5]=*(const __attribute__((address_space(3))) bf16x8*)(kp+4608);
  kf[6]=*(const __attribute__((address_space(3))) bf16x8*)(kp+6144); kf[7]=*(const __attribute__((address_space(3))) bf16x8*)(kp+6656);
}
__device__ __forceinline__ void kload2(bf16x8*kf,lds_cptr kp,int j){ kf[2*j]=*(const __attribute__((address_space(3))) bf16x8*)(kp+j*2048); kf[2*j+1]=*(const __attribute__((address_space(3))) bf16x8*)(kp+j*2048+512); }
__device__ __forceinline__ s16x4 vtr(lds_cptr p){ return __builtin_bit_cast(s16x4,__builtin_amdgcn_ds_read_tr16_b64_v4i16((__attribute__((address_space(3))) v4i16_t*)p)); }
__device__ __forceinline__ float rowmax(const f32x16&p0,const f32x16&p1){
  float a=max3f(p0[0],p0[1],p1[0]),b=max3f(p0[2],p0[3],p1[1]);a=max3f(a,p1[2],p1[3]);
  #pragma unroll
  for(int r=4;r<16;r+=4){a=max3f(a,p0[r],p0[r+1]);b=max3f(b,p0[r+2],p0[r+3]);a=max3f(a,p1[r],p1[r+1]);b=max3f(b,p1[r+2],p1[r+3]);}
  const float m=max2f(a,b);
  auto rr=__builtin_amdgcn_permlane32_swap(__float_as_uint(m),__float_as_uint(m),false,false);
  return max2f(__uint_as_float(rr[0]),__uint_as_float(rr[1]));
}
__device__ __forceinline__ void pv(f32x16*o,int vb,bf16x8 pa0,bf16x8 pa1,bf16x8 pa2,bf16x8 pa3){
  #pragma unroll
  for(int d0=0;d0<2;++d0){s16x4 lo[4],hi[4];
    #pragma unroll
    for(int ks=0;ks<4;++ks){
      asm volatile("ds_read_b64_tr_b16 %0,%1 offset:%c2":"=&v"(lo[ks]):"v"(vb),"i"(d0*4096+ks*1024):"memory");
      asm volatile("ds_read_b64_tr_b16 %0,%1 offset:%c2":"=&v"(hi[ks]):"v"(vb),"i"(d0*4096+ks*1024+512):"memory");}
    asm volatile("s_waitcnt lgkmcnt(0)":::"memory");SBAR();
    #define PK(k) (bf16x8){lo[k][0],lo[k][1],lo[k][2],lo[k][3],hi[k][0],hi[k][1],hi[k][2],hi[k][3]}
    o[d0]=__builtin_amdgcn_mfma_f32_32x32x16_bf16(pa0,PK(0),o[d0],0,0,0);
    o[d0]=__builtin_amdgcn_mfma_f32_32x32x16_bf16(pa1,PK(1),o[d0],0,0,0);
    o[d0]=__builtin_amdgcn_mfma_f32_32x32x16_bf16(pa2,PK(2),o[d0],0,0,0);
    o[d0]=__builtin_amdgcn_mfma_f32_32x32x16_bf16(pa3,PK(3),o[d0],0,0,0);
    #undef PK
  }
}

#ifndef ATTN_STORE16
#define ATTN_STORE16(p,v) (*(u32x4*)(p)=(v))
#endif
template<int THRL> __device__ __forceinline__ void attn_unit(int seqn,int qb,const bf16*Qh,const bf16*__restrict__ Kh,const bf16*__restrict__ Vh,bf16*Oh,char*shm){
  int tid_l=threadIdx.x; asm volatile("":"+v"(tid_l)); const int tid=tid_l,lane=tid&63,r32=lane&31,hi=lane>>5; const int wid=__builtin_amdgcn_readfirstlane(tid>>6);
  const int q0=qb*QB;
  const bf16*Qw=Qh+(long)(q0+wid*QBLK)*DM;
  const unsigned lds0=(unsigned)(uintptr_t)shm;
  float*wsf=(float*)(shm+LDS_WS)+wid*64;
  const bf16*ksrc=Kh+(long)lane*DM+wid*8;
  const bf16*vsrc=Vh+(long)(16*(wid&3)+(lane>>2))*DM+(wid>>2)*32+(lane&3)*8;
  const unsigned kdst=lds0+LDS_K+wid*1024, vdst=lds0+LDS_V+wid*1024;
  #define DMA_K(t,slot) glds16(ksrc+(long)(t)*KVBLK*DM,(unsigned)__builtin_amdgcn_readfirstlane(kdst+(slot)))
  #define DMA_V(t,slot) glds16(vsrc+(long)(t)*KVBLK*DM,(unsigned)__builtin_amdgcn_readfirstlane(vdst+(slot)))
  const int vb0=(int)(lds0+LDS_V)+((lane>>4)&1)*32+(lane&3)*8+(4*hi+((lane&15)>>2))*64;
  const char*Kbase=shm+LDS_K; bf16x8 kf[8];
  const lds_cptr shm3=(lds_cptr)shm; const lds_cptr kp0=shm3+LDS_K+hi*1024+r32*16; const lds_cptr vp0=shm3+LDS_V+((lane>>4)&1)*32+(lane&3)*8+(4*hi+((lane&15)>>2))*64;
  const int NT=seqn/KVBLK;
  DMA_K(0,0);DMA_V(0,0);DMA_K(1,SLOTB);
  bf16x8 qr[4];
  #pragma unroll
  for(int d0=0;d0<4;++d0)qr[d0]=*reinterpret_cast<const bf16x8*>(&Qw[(long)r32*DM+d0*16+hi*8]);
  float mhat=0.f,l_reg=0.f;f32x16 o[2];o[0]=f32x16{};o[1]=f32x16{};f32x16 negm=f32x16{};asm volatile("":"+v"(negm));
  #define CMASK(P0,P1,t) do{}while(0)
  bool resc=false;
  #define START(P0,P1) do{ const float rm=rowmax(P0,P1); resc=false; \
    { const float dl=rm; mhat=fadd_s(mhat,dl); \
      _Pragma("unroll") for(int r=0;r<16;++r){P0[r]=fsub_s(P0[r],dl);P1[r]=fsub_s(P1[r],dl);} \
      _Pragma("unroll") for(int r=0;r<16;++r)negm[r]=-mhat; asm volatile("":"+v"(negm)); } \
    _Pragma("unroll") for(int r=0;r<16;++r)P0[r]=__builtin_amdgcn_exp2f(P0[r]); }while(0)
  #define RESC() do{ if(resc){ asm volatile("s_waitcnt lgkmcnt(0)":::"memory"); \
      _Pragma("unroll") for(int d_=0;d_<2;++d_) _Pragma("unroll") for(int r=0;r<16;++r)o[d_][r]*=wsf[crow(r,hi)]; } }while(0)
  f32x16 pA0,pA1,pB0,pB1;
  int sl_prev=0,sl_cur=0,sl_next=SLOTB;
  #define ROT() do{sl_prev=sl_cur;sl_cur=sl_next;sl_next=(sl_next==(NSLOT-1)*SLOTB)?0:sl_next+SLOTB;}while(0)
  DMA_K(2,2*SLOTB);
  WAIT_BAR(3);
  qkt(pA0,pA1,Kbase,qr,negm,r32,hi);asm volatile("s_nop 15\n\ts_nop 7":"+v"(pA0),"+v"(pA1));CMASK(pA0,pA1,0);
  START(pA0,pA1);
  _Pragma("unroll") for(int r=0;r<16;++r)pA1[r]=__builtin_amdgcn_exp2f(pA1[r]);
  WAIT_BAR(0);
  DMA_K(3,0);DMA_V(1,SLOTB);
  ROT();
  kload8(kf,kp0+sl_cur);
  WAIT_BAR(2);
  s16x4 vlo[8],vhi[8]; u32x4 pw0,pw1,pw2,pw3;
  #define PKW(P,B) cvtpk_s(P[B],P[B+1])
  #define PAF(k) __builtin_bit_cast(bf16x8,pw##k)
  #define VFR(i) (bf16x8){vlo[i][0],vlo[i][1],vlo[i][2],vlo[i][3],vhi[i][0],vhi[i][1],vhi[i][2],vhi[i][3]}
  #define PIN(x) asm volatile("":"+v"(x))
  #define MX3(a,b,c) __builtin_fmaxf(__builtin_fmaxf((a),(b)),(c))
  #define GAPA(MF,A0,A1,A2,A3,W0,W1,PW) do{ MF; sacc+=A0; sacc+=A1; sacc+=A2; sacc+=A3; PIN(sacc); W0; W1; PIN(PW); SBAR(); }while(0)
  #define EX(v) __builtin_amdgcn_exp2f(v)
  #define GAPB(MF,X,B) do{ MF; X[B]=EX(X[B]); X[B+1]=EX(X[B+1]); X[B+2]=EX(X[B+2]); X[B+3]=EX(X[B+3]); PIN(X); SBAR(); }while(0)
  #define VRD(i) do{ vlo[i]=vtr(vp_+(((i)>>2)*4096+((i)&3)*1024)); vhi[i]=vtr(vp_+(((i)>>2)*4096+((i)&3)*1024+512)); }while(0)
  #define KRD(G,j) do{ if(G){ kload2(kf,kp0+sl_next,j); SBAR(); } }while(0)
  #define STEP(C0,C1,P0,P1,t,GK,GV,GL) do{ SBAR(); \
    const lds_cptr vp_=vp0+sl_prev; \
    VRD(0); SBAR(); float sacc=(P0[0]+P0[1]); \
    GAPA(C0=__builtin_amdgcn_mfma_f32_32x32x16_bf16(kf[0],qr[0],negm,0,0,0), P0[2],P0[3],P0[4],P0[5],     pw0[0]=PKW(P0,0), pw0[1]=PKW(P0,2), pw0); \
    VRD(4); SBAR(); GAPA(C1=__builtin_amdgcn_mfma_f32_32x32x16_bf16(kf[1],qr[0],negm,0,0,0), P0[6],P0[7],P0[8],P0[9],     pw0[2]=PKW(P0,4), pw0[3]=PKW(P0,6), pw0); \
    VRD(1); SBAR(); GAPA(C0=__builtin_amdgcn_mfma_f32_32x32x16_bf16(kf[2],qr[1],C0,0,0,0),   P0[10],P0[11],P0[12],P0[13], pw1[0]=PKW(P0,8), pw1[1]=PKW(P0,10), pw1); \
    VRD(5); SBAR(); GAPA(C1=__builtin_amdgcn_mfma_f32_32x32x16_bf16(kf[3],qr[1],C1,0,0,0),   P0[14],P0[15],P1[0],P1[1],   pw1[2]=PKW(P0,12),pw1[3]=PKW(P0,14), pw1); \
    VRD(2); SBAR(); GAPA(C0=__builtin_amdgcn_mfma_f32_32x32x16_bf16(kf[4],qr[2],C0,0,0,0),   P1[2],P1[3],P1[4],P1[5],     pw2[0]=PKW(P1,0), pw2[1]=PKW(P1,2), pw2); \
    VRD(6); SBAR(); GAPA(C1=__builtin_amdgcn_mfma_f32_32x32x16_bf16(kf[5],qr[2],C1,0,0,0),   P1[6],P1[7],P1[8],P1[9],     pw2[2]=PKW(P1,4), pw2[3]=PKW(P1,6), pw2); \
    VRD(3); SBAR(); GAPA(C0=__builtin_amdgcn_mfma_f32_32x32x16_bf16(kf[6],qr[3],C0,0,0,0),   P1[10],P1[11],P1[12],P1[13], pw3[0]=PKW(P1,8), pw3[1]=PKW(P1,10), pw3); \
    VRD(7); SBAR(); GAPA(C1=__builtin_amdgcn_mfma_f32_32x32x16_bf16(kf[7],qr[3],C1,0,0,0),   P1[14],P1[15],0.f,0.f,       pw3[2]=PKW(P1,12),pw3[3]=PKW(P1,14), pw3); \
    l_reg+=sacc; \
    if(GK){DMA_K((t)+3,sl_cur);} if(GV){DMA_V((t)+1,sl_next);} \
    CMASK(C0,C1,t); \
    { float a=MX3(C0[0],C0[1],C1[0]),b=MX3(C0[2],C0[3],C1[1]); a=MX3(a,C1[2],C1[3]); \
      _Pragma("unroll") for(int r=4;r<16;r+=4){a=MX3(a,C0[r],C0[r+1]);b=MX3(b,C0[r+2],C0[r+3]);a=MX3(a,C1[r],C1[r+1]);b=MX3(b,C1[r+2],C1[r+3]);} \
      float rm=__builtin_fmaxf(a,b); { auto rr=__builtin_amdgcn_permlane32_swap(__float_as_uint(rm),__float_as_uint(rm),false,false); rm=__builtin_fmaxf(__uint_as_float(rr[0]),__uint_as_float(rr[1])); } \
      resc=false; \
      if(__builtin_expect(__any(rm>(float)THRL),0)){ const float dl=__builtin_fmaxf(rm,0.f); mhat+=dl; \
        _Pragma("unroll") for(int r=0;r<16;++r){C0[r]-=dl;C1[r]-=dl;} \
        _Pragma("unroll") for(int r=0;r<16;++r)negm[r]=-mhat; asm volatile("":"+v"(negm)); \
        const float f=__builtin_amdgcn_exp2f(-dl); l_reg*=f; if(hi==0)wsf[r32]=f; resc=true; } } \
    SBAR(); \
    GAPB(o[0]=__builtin_amdgcn_mfma_f32_32x32x16_bf16(PAF(0),VFR(0),o[0],0,0,0), C0,0); \
    GAPB(o[1]=__builtin_amdgcn_mfma_f32_32x32x16_bf16(PAF(0),VFR(4),o[1],0,0,0), C0,4); \
    KRD(GL,0); GAPB(o[0]=__builtin_amdgcn_mfma_f32_32x32x16_bf16(PAF(1),VFR(1),o[0],0,0,0), C0,8); \
    KRD(GL,1); GAPB(o[1]=__builtin_amdgcn_mfma_f32_32x32x16_bf16(PAF(1),VFR(5),o[1],0,0,0), C0,12); \
    KRD(GL,2); GAPB(o[0]=__builtin_amdgcn_mfma_f32_32x32x16_bf16(PAF(2),VFR(2),o[0],0,0,0), C1,0); \
    KRD(GL,3); GAPB(o[1]=__builtin_amdgcn_mfma_f32_32x32x16_bf16(PAF(2),VFR(6),o[1],0,0,0), C1,4); \
    GAPB(o[0]=__builtin_amdgcn_mfma_f32_32x32x16_bf16(PAF(3),VFR(3),o[0],0,0,0), C1,8); \
    GAPB(o[1]=__builtin_amdgcn_mfma_f32_32x32x16_bf16(PAF(3),VFR(7),o[1],0,0,0), C1,12); \
    }while(0)
  int t=1;
  #undef CMASK
  #define CMASK(P0,P1,t) do{}while(0)
  for(;t+5<NT;t+=2){
    STEP(pB0,pB1,pA0,pA1,t,true,true,true);     WAIT_BAR(2); RESC(); ROT();
    STEP(pA0,pA1,pB0,pB1,t+1,true,true,true);   WAIT_BAR(2); RESC(); ROT();
  }
  #undef CMASK
  #define CMASK(P0,P1,t) do{}while(0)
  #define ENDW(tt) do{ if((tt)+3<NT){WAIT_BAR(2);} else if((tt)+2<NT){WAIT_BAR(1);} else {WAIT_BAR(0);} }while(0)
  for(;t+1<NT;t+=2){
    STEP(pB0,pB1,pA0,pA1,t,(t+3<NT),(t+1<NT),(t+1<NT));       ENDW(t);   RESC(); ROT();
    STEP(pA0,pA1,pB0,pB1,t+1,(t+4<NT),(t+2<NT),(t+2<NT));     ENDW(t+1); RESC(); ROT();
  }
  STEP(pB0,pB1,pA0,pA1,NT-1,false,false,false); RESC();
  { float sacc=pB0[0]+pB0[1]; _Pragma("unroll") for(int r=2;r<16;++r)sacc+=pB0[r]; _Pragma("unroll") for(int r=0;r<16;++r)sacc+=pB1[r]; l_reg+=sacc;
    pw0=(u32x4){PKW(pB0,0),PKW(pB0,2),PKW(pB0,4),PKW(pB0,6)};pw1=(u32x4){PKW(pB0,8),PKW(pB0,10),PKW(pB0,12),PKW(pB0,14)};pw2=(u32x4){PKW(pB1,0),PKW(pB1,2),PKW(pB1,4),PKW(pB1,6)};pw3=(u32x4){PKW(pB1,8),PKW(pB1,10),PKW(pB1,12),PKW(pB1,14)};
    SBAR(); pv(o,vb0+sl_cur,PAF(0),PAF(1),PAF(2),PAF(3)); }
  #undef PKW
  #undef PAF
  #undef VFR
  #undef PIN
  #undef MX3
  #undef GAPA
  #undef GAPB
  #undef EX
  #undef VRD
  #undef KRD
  #undef STEP
  #undef ENDW
  {auto rr=__builtin_amdgcn_permlane32_swap(__float_as_uint(l_reg),__float_as_uint(l_reg),false,false);l_reg=__uint_as_float(rr[0])+__uint_as_float(rr[1]);}
  if(hi==0)wsf[32+r32]=l_reg;asm volatile("s_waitcnt lgkmcnt(0)":::"memory");
  float rli[16];
  #pragma unroll
  for(int r=0;r<16;++r)rli[r]=__builtin_amdgcn_rcpf(wsf[32+crow(r,hi)]);
  bf16*Ow=Oh+(long)(q0+wid*QBLK)*DM;
  { bf16*stg=(bf16*)(shm+LDS_OST)+wid*2048;
    #pragma unroll
    for(int r=0;r<16;++r){const int orow=crow(r,hi);
      #pragma unroll
      for(int d0=0;d0<2;++d0)stg[orow*64+d0*32+r32]=__float2bfloat16(o[d0][r]*rli[r]);}
    asm volatile("s_waitcnt lgkmcnt(0)":::"memory");
    #pragma unroll
    for(int i=0;i<4;++i){const int row=i*8+(lane>>3),ch=lane&7; const u32x4 v=*(const u32x4*)(stg+row*64+ch*8); ATTN_STORE16(Ow+(long)row*DM+ch*8,v);} }
  asm volatile("s_waitcnt lgkmcnt(0)\n\ts_barrier":::"memory");
  #undef DMA_K
  #undef DMA_V
  #undef CMASK
  #undef START
  #undef RESC
  #undef ROT
}
constexpr int ATTN_LDS_BYTES=LDS_BYTES;
#undef SBAR
#undef WAIT_BAR
}
#define LAS __attribute__((address_space(3)))
typedef unsigned short bf16;
typedef float f32x4 __attribute__((ext_vector_type(4)));
typedef float f32x16 __attribute__((ext_vector_type(16)));
typedef unsigned v4u __attribute__((ext_vector_type(4)));
typedef unsigned v2u __attribute__((ext_vector_type(2)));
typedef short bf16x8 __attribute__((ext_vector_type(8)));
typedef short v4i16_t __attribute__((ext_vector_type(4)));
constexpr int NWAVES = 8, NTHR = 512;
constexpr int RING_BYTES = 131072, XLDS_OFF = RING_BYTES, LDS_BYTES = 147456;
constexpr int T_TOK = 49152, T_P = 32768, NPR = 16384, NSM = 2048;
constexpr float LOG2E = 1.4426950408889634f, C2 = 0.125f * 1.4426950408889634f, DN_ALPHA = 1.4142135623730951f;
constexpr size_t MiB = 1u << 20;
constexpr size_t E_ABIN = 0, E_ABOUT = 2621440, E_CDIN = 3670016, E_CDOUT = 5242880, E_XQ = 6291456, E_XKV = 8388608, E_XO = 12582912, E_FIN = 14680064, E_FOUT = 26214400;
constexpr size_t WS_DESC = 61 * MiB + 768 * 1024;
constexpr size_t WS_W = 0, WS_TAB = 61 * MiB, WS_MEMB = 62 * MiB, WS_KV = 67 * MiB, WS_GU = 87 * MiB, WS_XB = 127 * MiB, WS_BIG = 223 * MiB, WS_END = 487 * MiB;
constexpr size_t TAB_AFOLD = 0, TAB_POOLW = 131072, TAB_M1 = 196608, TAB_M2 = 262144;
constexpr size_t PM_OFF = 160 * MiB;
constexpr size_t DO_WTP = 0, DO_APR = 32 * MiB, DO_WTS = 64 * MiB, DO_DENSE = 80 * MiB;

__device__ __forceinline__ unsigned f2bf(float f) { unsigned u = __builtin_bit_cast(unsigned, f); return (u + 0x7fffu + ((u >> 16) & 1u)) >> 16; }
__device__ __forceinline__ unsigned pk2(float lo, float hi) { return f2bf(lo) | (f2bf(hi) << 16); }
__device__ __forceinline__ float bf2f(unsigned short b) { return __builtin_bit_cast(float, (unsigned)b << 16); }
__device__ __forceinline__ float bflo(unsigned w) { return __builtin_bit_cast(float, w << 16); }
__device__ __forceinline__ float bfhi(unsigned w) { return __builtin_bit_cast(float, w & 0xffff0000u); }
__device__ __forceinline__ float wave_sum(float v) {
#pragma unroll
    for (int o = 1; o < 64; o <<= 1) v += __shfl_xor(v, o);
    return v;
}

struct Args { const float* in[22]; float* out; unsigned char* ws; };
typedef const __attribute__((address_space(4))) Args* cargs_t;
template <class T> __device__ __forceinline__ T* as_global(T* p) { return (T*)(__attribute__((address_space(1))) T*)(uintptr_t)p; }
__device__ __forceinline__ const float* karg(cargs_t p, int k) { asm volatile("" : "+s"(p)); return as_global(p->in[k]); }
struct Ctx {
    LAS unsigned char* lds; int tid, lane, wave, G, gw, NGW, bid;
    const float *rel_bias, *q_norm, *k_norm, *ln_g, *ln_b;
    float* out; unsigned char* ws;
    __device__ __forceinline__ bf16* W() const { return (bf16*)(ws + WS_W); }
    __device__ __forceinline__ bf16* TAB() const { return (bf16*)(ws + WS_TAB); }
    __device__ __forceinline__ bf16* MEMB() const { return (bf16*)(ws + WS_MEMB); }
    __device__ __forceinline__ bf16* KV() const { return (bf16*)(ws + WS_KV); }
    __device__ __forceinline__ bf16* GT() const { return (bf16*)(ws + WS_GU); }
    __device__ __forceinline__ bf16* UT() const { return (bf16*)(ws + WS_GU) + 10 * 1048576; }
    __device__ __forceinline__ bf16* XB() const { return (bf16*)(ws + WS_XB); }
    __device__ __forceinline__ bf16* BIG() const { return (bf16*)(ws + WS_BIG); }
};

__device__ __forceinline__ void tr_item(const float* W, int ldw, int n0s, int k0, bf16* WT, int ldt, int n0d, LAS float* scr, int lane) {
#pragma unroll 8
    for (int i = 0; i < 32; ++i) { const int kk = 2 * i + (lane >> 5); scr[kk * 33 + (lane & 31)] = W[(size_t)(k0 + kk) * ldw + n0s + (lane & 31)]; }
    asm volatile("s_waitcnt lgkmcnt(0)" ::: "memory");
    const int c = lane & 7;
#pragma unroll
    for (int j = 0; j < 4; ++j) { const int n = (lane >> 3) + 8 * j; const LAS float* s = scr + (8 * c) * 33 + n;
        v4u o; o.x = pk2(s[0 * 33], s[1 * 33]); o.y = pk2(s[2 * 33], s[3 * 33]); o.z = pk2(s[4 * 33], s[5 * 33]); o.w = pk2(s[6 * 33], s[7 * 33]);
        *(v4u*)(WT + (size_t)(n0d + n) * ldt + k0 + 8 * c) = o; }
    asm volatile("s_waitcnt lgkmcnt(0)" ::: "memory");
}
__device__ __forceinline__ int src_col(int map, int d) {
    if (map == 1) return d < 768 ? d : d < 1024 ? 2304 + (d - 768) : d < 1792 ? 768 + (d - 1024) : 1536 + (d - 1792);
    if (map == 2) return d < 768 ? d : d < 1024 ? 1280 + (d - 768) : d < 1280 ? 768 + (d - 1024) : 1024 + (d - 1280);
    if (map == 3) return ((d >> 7) & 1) * 2816 + (d >> 8) * 128 + (d & 127);
    return d;
}
__device__ __forceinline__ void tr_matrix(const Ctx& C, const float* W, int K, int N, bf16* WT, int map) {
    LAS float* scr = (LAS float*)(C.lds + C.wave * 16384);
    const int nblk = N / 32, items = (K / 64) * nblk;
    for (int it = C.gw; it < items; it += C.NGW) { const int kb = it / nblk, nb = it % nblk; tr_item(W, N, src_col(map, 32 * nb), 64 * kb, WT, K, 32 * nb, scr, C.lane); }
}
__device__ __forceinline__ void cvt_plain(const Ctx& C, const float* src, bf16* dst, size_t n) {
    const size_t gt = (size_t)C.bid * NTHR + C.tid, NG = (size_t)C.G * NTHR;
    for (size_t i = gt * 8; i < n; i += NG * 8) { const f32x4 a = *(const f32x4*)(src + i), b = *(const f32x4*)(src + i + 4);
        v4u o; o.x = pk2(a[0], a[1]); o.y = pk2(a[2], a[3]); o.z = pk2(b[0], b[1]); o.w = pk2(b[2], b[3]); *(v4u*)(dst + i) = o; }
}
__device__ __forceinline__ void prologue(const Ctx& C, cargs_t AR) {
    tr_matrix(C, karg(AR, 5), 1024, 2560, C.W() + E_ABIN, 1);
    tr_matrix(C, karg(AR, 8), 1024, 1024, C.W() + E_ABOUT, 0);
    tr_matrix(C, karg(AR, 9), 1024, 1536, C.W() + E_CDIN, 2);
    tr_matrix(C, karg(AR, 14), 1024, 1024, C.W() + E_CDOUT, 0);
    for (int l = 0; l < 2; ++l) {
        tr_matrix(C, karg(AR, 16) + (size_t)l * 1024 * 2048, 1024, 2048, C.W() + E_XKV + (size_t)l * 2097152, 0);
        tr_matrix(C, karg(AR, 17) + (size_t)l * 1048576, 1024, 1024, C.W() + E_XO + (size_t)l * 1048576, 0);
        tr_matrix(C, karg(AR, 18) + (size_t)l * 1024 * 5632, 1024, 5632, C.W() + E_FIN + (size_t)l * 5767168, 3);
        tr_matrix(C, karg(AR, 19) + (size_t)l * 2816 * 1024, 2816, 1024, C.W() + E_FOUT + (size_t)l * 2883584, 0);
    }
    cvt_plain(C, karg(AR, 15), C.W() + E_XQ, 2 * 1048576);
    cvt_plain(C, karg(AR, 2), C.MEMB(), 512 * 1024);
    cvt_plain(C, karg(AR, 3), C.MEMB() + 512 * 1024, 2048 * 1024);
    cvt_plain(C, karg(AR, 0), C.XB(), (size_t)T_P * 1024);
    cvt_plain(C, karg(AR, 1), C.XB() + (size_t)T_P * 1024, (size_t)(T_TOK - T_P) * 1024);
    const int gt = C.bid * NTHR + C.tid, NG = C.G * NTHR;
    const float* fw = karg(AR, 7); const float* fg = karg(AR, 6); const float* pw = karg(AR, 12); const float* ps = karg(AR, 13);
    for (int i = gt; i < 512 * 256; i += NG) {
        const int row = i >> 8, col = i & 255, reim = row >> 8, g = (row >> 6) & 3, e = row & 63, g2 = col >> 6, k = col & 63; float v = 0.f;
        if (g == g2) { const float* w = fw + g * 4096 + e; float s = 0.f;
            for (int c = 0; c < 64; ++c) { const float rev = (float)((k * c) & 63) * (1.f / 64.f); s += (reim ? -__builtin_amdgcn_sinf(rev) : __builtin_amdgcn_cosf(rev)) * w[c * 64]; }
            v = s * 0.125f * fg[g * 64 + k]; }
        C.TAB()[TAB_AFOLD + i] = (bf16)f2bf(v); }
    for (int i = gt; i < 256 * 256; i += NG) {
        const int row = i >> 8, col = i & 255; { const int g = row >> 6, e = row & 63, g2 = col >> 6, c = col & 63;
            C.TAB()[TAB_POOLW + i] = (bf16)f2bf(g == g2 ? pw[g * 4096 + c * 64 + e] * ps[row] : 0.f); }
        { const int ri = row >> 7, k1 = row & 127, ri2 = col >> 7, n1 = col & 127; const float rev = (float)((k1 * n1) & 127) * (1.f / 128.f);
            const float cs = __builtin_amdgcn_cosf(rev), sn = __builtin_amdgcn_sinf(rev); const float v = (ri == ri2) ? cs : (ri == 0 ? sn : -sn);
            C.TAB()[TAB_M1 + i] = (bf16)f2bf(v * 0.08838834764831845f);
            C.TAB()[TAB_M2 + i] = (bf16)f2bf(ri == 0 ? (ri2 == 0 ? cs : sn) * 0.08838834764831845f : 0.f); } }
    bf16* DENSE = (bf16*)((unsigned char*)C.out + DO_DENSE);
    for (int i = gt; i < 2048 * 4096; i += NG) { const int k = i >> 12, col = i & 4095, ri = col >> 11, n = col & 2047; const float rev = (float)((k * n) & 2047) * (1.f / 2048.f);
        DENSE[i] = (bf16)f2bf((ri ? __builtin_amdgcn_sinf(rev) : __builtin_amdgcn_cosf(rev)) * 0.022097086912079608f); }
}

__device__ __forceinline__ void ln_pass(const Ctx& C, int idx) {
    const float* g = C.ln_g + idx * 1024 + C.lane * 4; const float* b = C.ln_b + idx * 1024 + C.lane * 4;
    f32x4 gv[4], bv[4];
#pragma unroll
    for (int j = 0; j < 4; ++j) { gv[j] = *(const f32x4*)(g + 256 * j); bv[j] = *(const f32x4*)(b + 256 * j); }
    for (int row = C.gw; row < T_TOK; row += C.NGW) {
        float* xr = C.out + (size_t)row * 1024 + C.lane * 4; f32x4 v[4]; float s = 0.f;
#pragma unroll
        for (int j = 0; j < 4; ++j) { v[j] = *(const f32x4*)(xr + 256 * j); s += (v[j][0] + v[j][1]) + (v[j][2] + v[j][3]); }
        const float mean = wave_sum(s) * (1.f / 1024.f); float s2 = 0.f;
#pragma unroll
        for (int j = 0; j < 4; ++j) { v[j] = v[j] - mean; s2 += (v[j][0] * v[j][0] + v[j][1] * v[j][1]) + (v[j][2] * v[j][2] + v[j][3] * v[j][3]); }
        const float rstd = 1.f / sqrtf(wave_sum(s2) * (1.f / 1024.f) + 1e-5f);
        bf16* xb = C.XB() + (size_t)row * 1024 + C.lane * 4;
#pragma unroll
        for (int j = 0; j < 4; ++j) { const f32x4 o = v[j] * rstd * gv[j] + bv[j]; *(f32x4*)(xr + 256 * j) = o;
            v2u w; w.x = pk2(o[0], o[1]); w.y = pk2(o[2], o[3]); *(v2u*)(xb + 256 * j) = w; }
    }
}
__device__ __forceinline__ void gln_pass(const Ctx& C) {
    for (int row = C.gw; row < T_TOK; row += C.NGW) {
        bf16* p = C.BIG() + (size_t)row * 2560 + 768 + C.lane * 4; const v2u w = *(const v2u*)p;
        float x0 = bflo(w.x), x1 = bfhi(w.x), x2 = bflo(w.y), x3 = bfhi(w.y); float s = (x0 + x1) + (x2 + x3);
#pragma unroll
        for (int o = 1; o < 16; o <<= 1) s += __shfl_xor(s, o);
        const float mu = s * (1.f / 64.f); x0 -= mu; x1 -= mu; x2 -= mu; x3 -= mu; float q = (x0 * x0 + x1 * x1) + (x2 * x2 + x3 * x3);
#pragma unroll
        for (int o = 1; o < 16; o <<= 1) q += __shfl_xor(q, o);
        const float rstd = 1.f / sqrtf(q * (1.f / 64.f) + 1e-5f);
        v2u o; o.x = pk2(x0 * rstd, x1 * rstd); o.y = pk2(x2 * rstd, x3 * rstd); *(v2u*)p = o;
    }
}
__device__ __forceinline__ void rope_pass(const Ctx& C) {
    const int p = C.lane & 31, half = C.lane >> 5; const float freq = __builtin_amdgcn_exp2f(-(float)(p & 15) * 0.8304820237218407f) * 0.15915494309189535f;
    const float gq0 = C.q_norm[2 * p], gq1 = C.q_norm[2 * p + 1], gk0 = C.k_norm[2 * p], gk1 = C.k_norm[2 * p + 1];
    for (int row = C.gw; row < T_TOK; row += C.NGW) {
        const int n = row < T_P ? (row & (NPR - 1)) : ((row - T_P) & (NSM - 1)); const int pos = p < 16 ? (n >> 6) : (n & 63);
        float rev = (float)pos * freq; rev -= rintf(rev); const float cs = __builtin_amdgcn_cosf(rev), sn = __builtin_amdgcn_sinf(rev);
        bf16* zr = C.BIG() + (size_t)row * 1536 + 2 * p;
#pragma unroll
        for (int it = 0; it < 8; ++it) { const int head = 2 * it + half; const bool isq = head < 12; bf16* ptr = zr + (isq ? head * 64 : 1024 + (head - 12) * 64);
            const unsigned w = *(const unsigned*)ptr; float x1 = bflo(w), x2 = bfhi(w); float ss = x1 * x1 + x2 * x2;
#pragma unroll
            for (int o = 1; o < 32; o <<= 1) ss += __shfl_xor(ss, o);
            const float rs = 1.f / sqrtf(ss * (1.f / 64.f) + 1e-6f); x1 *= rs * (isq ? gq0 : gk0); x2 *= rs * (isq ? gq1 : gk1);
            const float sc = isq ? C2 : 1.f; *(unsigned*)ptr = pk2((x1 * cs - x2 * sn) * sc, (x1 * sn + x2 * cs) * sc); }
    }
}
__device__ __forceinline__ void pool_pass(const Ctx& C) {
    bf16* PM = (bf16*)((unsigned char*)C.BIG() + PM_OFF);
    const int gt = C.bid * NTHR + C.tid, NG = C.G * NTHR;
    for (int i = gt; i < T_TOK * 32; i += NG) { const int row = i >> 5, ch = i & 31, hw = 1 << (ch >> 3);
        int n, N, rb; if (row < T_P) { n = row & (NPR - 1); N = NPR; rb = row - n; } else { n = (row - T_P) & (NSM - 1); N = NSM; rb = row - n; }
        const int lo = n - hw < 0 ? 0 : n - hw, hi = n + hw > N ? N : n + hw; float a[8];
#pragma unroll
        for (int j = 0; j < 8; ++j) a[j] = 0.f;
        for (int s = lo; s < hi; ++s) { const v4u w = *(const v4u*)(C.BIG() + (size_t)(rb + s) * 1536 + 768 + ch * 8);
            a[0] += bflo(w.x); a[1] += bfhi(w.x); a[2] += bflo(w.y); a[3] += bfhi(w.y); a[4] += bflo(w.z); a[5] += bfhi(w.z); a[6] += bflo(w.w); a[7] += bfhi(w.w); }
        const float inv = 1.f / (float)(hi - lo); const v4u w = *(const v4u*)(C.BIG() + (size_t)row * 1536 + 768 + ch * 8);
        v4u o; o.x = pk2(a[0] * inv - bflo(w.x), a[1] * inv - bfhi(w.x)); o.y = pk2(a[2] * inv - bflo(w.y), a[3] * inv - bfhi(w.y));
        o.z = pk2(a[4] * inv - bflo(w.z), a[5] * inv - bfhi(w.z)); o.w = pk2(a[6] * inv - bflo(w.w), a[7] * inv - bfhi(w.w));
        *(v4u*)(PM + (size_t)row * 256 + ch * 8) = o; }
}
__device__ __forceinline__ int crow(int r, int hi) { return (r & 3) + 8 * (r >> 2) + 4 * hi; }
__device__ __forceinline__ int t5_bucket(int rel) {
    const int ret = rel > 0 ? 16 : 0; const int n = rel < 0 ? -rel : rel; if (n < 8) return ret + n;
    const float v = logf((float)n / 8.0f) / logf(128.0f) * 8.0f; int large = 8 + (int)v; if (large > 15) large = 15; return ret + large;
}
constexpr int DIL_TAB_BYTES = 19456, DIL_VROW = 144, DIL_VST = 32 * DIL_VROW;
__device__ __forceinline__ void dil_phase(const Ctx& C) {
    __syncthreads();
    LAS float* tab = (LAS float*)C.lds;
    LAS unsigned char* vst = C.lds + DIL_TAB_BYTES + C.wave * DIL_VST;
    LAS float* wsf = (LAS float*)(C.lds + DIL_TAB_BYTES + NWAVES * DIL_VST + C.wave * 256);
    for (int i = C.tid; i < 12 * 387; i += NTHR) { const int h = i / 387, rem = i % 387, pat = rem / 129, j = rem % 129; const int rel = (j - 64) << (2 * pat);
        tab[(h * 3 + pat) * 132 + j] = C.rel_bias[t5_bucket(rel) * 12 + h] * LOG2E; }
    __syncthreads();
    const int lane = C.lane, r32 = lane & 31, hi = lane >> 5;
    const int tq = (lane & 15) >> 2, tp = lane & 3, tblk = (lane >> 4) & 1;
    const LAS unsigned char* vrd = vst + (4 * hi + tq) * DIL_VROW + tblk * 32 + tp * 8;
    for (int wu = C.bid; wu < 2304; wu += C.G) {
        const int half = wu & 1, hs = wu >> 1, h = hs % 12, span = hs / 12; int rowbase, N, sp;
        if (span < 64) { rowbase = (span >> 5) * NPR; N = NPR; sp = span & 31; } else { const int s2 = span - 64; rowbase = T_P + (s2 >> 2) * NSM; N = NSM; sp = s2 & 3; }
        const int t0 = sp * 512 + half * 8 + C.wave;
        bf16* Zb = C.BIG() + (size_t)rowbase * 2560;
        bf16x8 qr[4];
#pragma unroll
        for (int d0 = 0; d0 < 4; ++d0) qr[d0] = *(const bf16x8*)(Zb + (size_t)(t0 + 16 * r32) * 2560 + h * 64 + d0 * 16 + hi * 8);
        const bf16* Kc = Zb + 1024 + h * 64 + hi * 8; const bf16* Vc = Zb + 1792 + h * 64 + (lane & 7) * 8;
        float mrun = -1e30f, lsum = 0.f; f32x16 o0 = f32x16{}, o1 = f32x16{};
        for (int pat = 0; pat < 3; ++pat) {
            const int sh = 2 * pat, dil = 1 << sh, nch = pat == 0 ? 20 : pat == 1 ? 8 : 5, qs = 16 >> sh;
            const LAS float* tb = tab + (h * 3 + pat) * 132 + 64;
            for (int c = 0; c < nch; ++c) {
                const int m0 = -64 + 32 * c;
                int kt = t0 + (m0 + r32) * dil; kt = kt < 0 ? 0 : (kt > N - 1 ? N - 1 : kt);
                bf16x8 kf[4]; v4u vv[4];
#pragma unroll
                for (int d0 = 0; d0 < 4; ++d0) kf[d0] = *(const bf16x8*)(Kc + (size_t)kt * 2560 + d0 * 16);
#pragma unroll
                for (int i = 0; i < 4; ++i) { int vt = t0 + (m0 + (lane >> 3) + 8 * i) * dil; vt = vt < 0 ? 0 : (vt > N - 1 ? N - 1 : vt); vv[i] = *(const v4u*)(Vc + (size_t)vt * 2560); }
                f32x16 p = f32x16{};
#pragma unroll
                for (int d0 = 0; d0 < 4; ++d0) p = __builtin_amdgcn_mfma_f32_32x32x16_bf16(kf[d0], qr[d0], p, 0, 0, 0);
#pragma unroll
                for (int i = 0; i < 4; ++i) *(LAS v4u*)(vst + ((lane >> 3) + 8 * i) * DIL_VROW + (lane & 7) * 16) = vv[i];
                float rm = -INFINITY;
#pragma unroll
                for (int r = 0; r < 16; ++r) { const int mm = m0 + crow(r, hi), relj = mm - qs * r32, key = t0 + mm * dil;
                    const bool valid = relj >= -64 && relj <= 64 && key >= 0 && key < N; const int ix = relj < -64 ? -64 : (relj > 64 ? 64 : relj);
                    const float s = valid ? p[r] + tb[ix] : -INFINITY; p[r] = s; rm = fmaxf(rm, s); }
                rm = fmaxf(rm, __shfl_xor(rm, 32));
                const float mnew = fmaxf(mrun, rm), f = __builtin_amdgcn_exp2f(mrun - mnew); float psum = 0.f;
#pragma unroll
                for (int r = 0; r < 16; ++r) { p[r] = __builtin_amdgcn_exp2f(p[r] - mnew); psum += p[r]; }
                lsum = lsum * f + psum;
                if (__any(mnew > mrun)) {
                    if (hi == 0) wsf[r32] = f;
                    asm volatile("s_waitcnt lgkmcnt(0)" ::: "memory");
#pragma unroll
                    for (int r = 0; r < 16; ++r) { const float fr = wsf[crow(r, hi)]; o0[r] *= fr; o1[r] *= fr; }
                }
                mrun = mnew;
                v4u pa0, pa1;
                pa0.x = pk2(p[0], p[1]); pa0.y = pk2(p[2], p[3]); pa0.z = pk2(p[4], p[5]); pa0.w = pk2(p[6], p[7]);
                pa1.x = pk2(p[8], p[9]); pa1.y = pk2(p[10], p[11]); pa1.z = pk2(p[12], p[13]); pa1.w = pk2(p[14], p[15]);
                asm volatile("s_waitcnt lgkmcnt(0)" ::: "memory");
#pragma unroll
                for (int d0 = 0; d0 < 2; ++d0)
#pragma unroll
                    for (int ks = 0; ks < 2; ++ks) {
                        const v4i16_t lo = __builtin_amdgcn_ds_read_tr16_b64_v4i16((LAS v4i16_t*)(vrd + ks * 16 * DIL_VROW + d0 * 64));
                        const v4i16_t hh = __builtin_amdgcn_ds_read_tr16_b64_v4i16((LAS v4i16_t*)(vrd + (ks * 16 + 8) * DIL_VROW + d0 * 64));
                        const bf16x8 vf = (bf16x8){lo[0], lo[1], lo[2], lo[3], hh[0], hh[1], hh[2], hh[3]};
                        const bf16x8 pf = __builtin_bit_cast(bf16x8, ks ? pa1 : pa0);
                        if (d0 == 0) o0 = __builtin_amdgcn_mfma_f32_32x32x16_bf16(pf, vf, o0, 0, 0, 0); else o1 = __builtin_amdgcn_mfma_f32_32x32x16_bf16(pf, vf, o1, 0, 0, 0);
                    }
                asm volatile("s_waitcnt lgkmcnt(0)" ::: "memory");
            }
        }
        lsum += __shfl_xor(lsum, 32);
        if (hi == 0) wsf[r32] = lsum;
        asm volatile("s_waitcnt lgkmcnt(0)" ::: "memory");
#pragma unroll
        for (int r = 0; r < 16; ++r) { const int q = crow(r, hi); const float rl = 1.f / wsf[q]; bf16* op = Zb + (size_t)(t0 + 16 * q) * 2560 + h * 64 + r32;
            op[0] = (bf16)f2bf(o0[r] * rl); op[32] = (bf16)f2bf(o1[r] * rl); }
        asm volatile("s_waitcnt lgkmcnt(0)" ::: "memory");
    }
    __syncthreads();
}

__device__ __forceinline__ void gqa_phase(const Ctx& C, char* shm) {
    __syncthreads();
    for (int u = C.bid; u < 1536 + 768; u += C.G) {
        int b, g, qb, r, N, rowbase;
        if (u < 1536) { r = u % 3; qb = (u / 3) & 63; g = (u / 192) & 3; b = u / 768; N = NPR; rowbase = b * NPR; }
        else { const int v = u - 1536; r = v % 3; qb = (v / 3) & 7; g = (v / 24) & 3; b = v / 96; N = NSM; rowbase = T_P + b * NSM; }
        attn_body::bf16* Z = (attn_body::bf16*)C.BIG() + (size_t)rowbase * 1536;
        attn_body::attn_unit<8>(N, qb, Z + (3 * g + r) * 64, Z + 1024 + g * 64, Z + 1280 + g * 64, Z + (3 * g + r) * 64, shm);
    }
    __syncthreads();
}
enum { K_BF16 = 0, K_SWIGLU = 1, K_RESID = 2, K_SOFTMAX = 3, K_TWID = 4 };
enum { G_KV = 0, G_ABIN, G_F0P, G_F0S, G_S1, G_DENSE, G_S2, G_ABOUT, G_GT0, G_UT0, G_XSP0, G_XSS0, G_XOP0, G_XOS0, G_FIN0, G_FOUT0,
       G_CDIN, G_POOL, G_CDOUT, G_GT1, G_UT1, G_XSP1, G_XSS1, G_XOP1, G_XOS1, G_FIN1, G_FOUT1, G_NONE = -1 };
typedef pg8::GD GD;
__device__ __forceinline__ void fill_gd(GD& d, int id, const Ctx& C, cargs_t AR) {
    d.kind = K_BF16; d.K = 1024; d.lda = 1024; d.ldb = 1024; d.nM = 192; d.nN = 4; d.nb = 1; d.bdiv = 1;
    d.A = (const char*)C.XB(); d.B = (const char*)C.W(); d.aHi = d.aLo = d.bHi = d.bLo = 0;
    d.O = C.BIG(); d.cs_hi = d.cs_lo = 0; d.obdiv = 1; d.ldc = 1024; d.pn_stride = 256; d.bj_stride = 128; d.nscale = 0; d.scale0 = 1.f; d.rows_valid = 256;
    d.r0 = d.r1 = C.out; d.out = C.out; d.pad = 0; d.split = 0x7fffffff; d.row0 = 0; d.rpb = 0;
    bf16* DO = (bf16*)C.out; const int l = (id >= G_GT1) ? 1 : 0;
    switch (id) {
    case G_KV: d.A = (const char*)C.MEMB(); d.B = (const char*)(C.W() + E_XKV); d.nM = 10; d.nN = 8; d.nb = 2; d.bHi = 2097152 * 2; d.O = C.KV(); d.cs_hi = 2560 * 2048; d.ldc = 2048; break;
    case G_ABIN: d.B = (const char*)(C.W() + E_ABIN); d.nN = 10; d.ldc = 2560; d.nscale = 3; d.scale0 = C2; break;
    case G_F0P: d.K = 256; d.A = (const char*)(C.TAB() + TAB_AFOLD); d.lda = 256; d.nM = 2; d.nN = 64; d.nb = 2;
        d.B = (const char*)(C.BIG() + 768); d.ldb = 128 * 2560; d.bHi = (size_t)NPR * 2560 * 2; d.O = DO + DO_WTP / 2; d.cs_hi = 256 * 32768; d.ldc = 32768; d.pn_stride = 512; d.bj_stride = 256; break;
    case G_F0S: d.K = 256; d.A = (const char*)(C.TAB() + TAB_AFOLD); d.lda = 256; d.nM = 2; d.nN = 8; d.nb = 8;
        d.B = (const char*)(C.BIG() + (size_t)T_P * 2560 + 768); d.ldb = 2560; d.bHi = (size_t)NSM * 2560 * 2; d.O = DO + DO_WTS / 2; d.cs_hi = 256 * 4096; d.ldc = 4096; break;
    case G_S1: d.kind = K_TWID; d.K = 256; d.A = (const char*)(C.TAB() + TAB_M1); d.lda = 256; d.nM = 1; d.nN = 1; d.nb = 256; d.B = (const char*)(DO + DO_WTP / 2); d.ldb = 256; d.bHi = 131072; d.O = DO + DO_APR / 2; break;
    case G_DENSE: d.K = 4096; d.A = (const char*)(DO + DO_DENSE / 2); d.lda = 4096; d.nM = 8; d.nN = 1; d.nb = 8; d.B = (const char*)(DO + DO_WTS / 2); d.ldb = 4096; d.bHi = (size_t)256 * 4096 * 2;
        d.O = C.BIG() + (size_t)T_P * 2560 + 768; d.cs_hi = (size_t)NSM * 2560; d.ldc = 2560; break;
    case G_S2: d.K = 256; d.A = (const char*)(C.TAB() + TAB_M2); d.lda = 256; d.nM = 1; d.nN = 1; d.nb = 256; d.bdiv = 128; d.B = (const char*)(DO + DO_APR / 2); d.ldb = 32768; d.bHi = (size_t)256 * 32768 * 2; d.bLo = 512;
        d.O = C.BIG() + 768; d.cs_hi = (size_t)NPR * 2560; d.cs_lo = 2560; d.obdiv = 128; d.ldc = 128 * 2560; d.rows_valid = 128; break;
    case G_ABOUT: d.kind = K_RESID; d.A = (const char*)C.BIG(); d.lda = 2560; d.B = (const char*)(C.W() + E_ABOUT); d.r0 = karg(AR, 0); d.r1 = karg(AR, 1); d.split = T_P; break;
    case G_GT0: case G_GT1: d.K = 256; d.A = (const char*)(C.KV() + (size_t)l * 2560 * 2048); d.lda = 2048; d.nM = 1; d.nN = 4; d.nb = 40; d.bdiv = 4; d.aHi = (size_t)256 * 2048 * 2; d.aLo = 512;
        d.B = (const char*)(C.W() + E_XQ + (size_t)l * 1048576); d.bLo = 512; d.O = C.GT(); d.cs_hi = 1048576; d.cs_lo = 256 * 1024; d.obdiv = 4; d.nscale = 1 << 20; d.scale0 = 0.0625f * LOG2E; break;
    case G_UT0: case G_UT1: d.K = 256; d.A = (const char*)(C.W() + E_XO + (size_t)l * 1048576); d.nM = 4; d.nN = 1; d.nb = 40; d.bdiv = 4; d.aLo = 512;
        d.B = (const char*)(C.KV() + (size_t)l * 2560 * 2048 + 1024); d.ldb = 2048; d.bHi = (size_t)256 * 2048 * 2; d.bLo = 512; d.O = C.UT(); d.cs_hi = 1048576; d.cs_lo = 256; d.obdiv = 4; break;
    case G_XSP0: case G_XSP1: d.kind = K_SOFTMAX; d.nM = 64; d.nb = 2; d.aHi = (size_t)NPR * 1024 * 2; d.B = (const char*)C.GT(); d.bHi = 2097152; d.cs_hi = (size_t)NPR * 1024; break;
    case G_XSS0: case G_XSS1: d.kind = K_SOFTMAX; d.A = (const char*)(C.XB() + (size_t)T_P * 1024); d.nM = 8; d.nb = 8; d.aHi = (size_t)NSM * 1024 * 2; d.B = (const char*)(C.GT() + 2 * 1048576); d.bHi = 2097152;
        d.O = C.BIG() + (size_t)T_P * 1024; d.cs_hi = (size_t)NSM * 1024; break;
    case G_XOP0: case G_XOP1: d.kind = K_RESID; d.A = (const char*)C.BIG(); d.nM = 64; d.nb = 2; d.aHi = (size_t)NPR * 1024 * 2; d.B = (const char*)C.UT(); d.bHi = 2097152; d.rpb = NPR; break;
    case G_XOS0: case G_XOS1: d.kind = K_RESID; d.A = (const char*)(C.BIG() + (size_t)T_P * 1024); d.nM = 8; d.nb = 8; d.aHi = (size_t)NSM * 1024 * 2; d.B = (const char*)(C.UT() + 2 * 1048576); d.bHi = 2097152; d.row0 = T_P; d.rpb = NSM; break;
    case G_FIN0: case G_FIN1: d.kind = K_SWIGLU; d.B = (const char*)(C.W() + E_FIN + (size_t)l * 5767168); d.nN = 22; d.ldc = 2816; break;
    case G_FOUT0: case G_FOUT1: d.kind = K_RESID; d.K = 2816; d.A = (const char*)C.BIG(); d.lda = 2816; d.B = (const char*)(C.W() + E_FOUT + (size_t)l * 2883584); d.ldb = 2816; break;
    case G_CDIN: d.B = (const char*)(C.W() + E_CDIN); d.nN = 6; d.ldc = 1536; break;
    case G_POOL: d.K = 256; d.A = (const char*)C.BIG() + PM_OFF; d.lda = 256; d.B = (const char*)(C.TAB() + TAB_POOLW); d.ldb = 256; d.nN = 1; d.O = C.BIG() + 768; d.ldc = 1536; break;
    case G_CDOUT: d.kind = K_RESID; d.A = (const char*)C.BIG(); d.lda = 1536; d.B = (const char*)(C.W() + E_CDOUT); break;
    default: break;
    }
    d.hA = (size_t)128 * d.lda * 2; d.hB = (size_t)128 * d.ldb * 2; d.tA = 2 * d.hA; d.tB = 2 * d.hB;
    d.pm_stride = (size_t)256 * d.ldc;
    if (id == G_F0P) { d.hB = 2560 * 2; d.tB = 2 * 2560 * 2; d.pm_stride = 128; }
    if (id == G_F0S) { d.pm_stride = 2048; }
    if (id == G_UT0 || id == G_UT1) { d.tB = 0; }
    if (id == G_GT0 || id == G_GT1) { d.tA = 0; }
}

#ifndef MAXSTEP
#define MAXSTEP 26
#endif
constexpr int NSTEP = MAXSTEP, NGEMM = 27;
__global__ void __launch_bounds__(NTHR, 2) mega_fwd(Args args) {
    extern __shared__ __attribute__((aligned(16))) unsigned char lds[];
    cg::grid_group grid = cg::this_grid();
    cargs_t AR = (cargs_t)__builtin_amdgcn_kernarg_segment_ptr();
    { Ctx C0;
      C0.lds = (LAS unsigned char*)lds; C0.tid = threadIdx.x; C0.lane = C0.tid & 63; C0.wave = __builtin_amdgcn_readfirstlane(C0.tid >> 6); C0.G = gridDim.x; C0.bid = blockIdx.x;
      C0.gw = C0.bid * NWAVES + C0.wave; C0.NGW = C0.G * NWAVES;
      C0.rel_bias = nullptr; C0.q_norm = nullptr; C0.k_norm = nullptr; C0.ln_g = nullptr; C0.ln_b = nullptr;
      C0.out = as_global(AR->out); C0.ws = as_global(AR->ws);
      GD* table0 = (GD*)(C0.ws + WS_DESC);
      if (blockIdx.x == 0 && C0.tid < NGEMM) { GD d; fill_gd(d, C0.tid, C0, AR); table0[C0.tid] = d; }
      prologue(C0, AR); }
    grid.sync();
#define MK_CTX(C) Ctx C; { int tid = threadIdx.x, G = gridDim.x, bid = blockIdx.x; cargs_t ap = AR; asm volatile("" : "+s"(ap)); unsigned char* ws = as_global(ap->ws); float* out = as_global(ap->out); \
          const float *p0 = as_global(ap->in[4]), *p1 = as_global(ap->in[10]), *p2 = as_global(ap->in[11]), *p3 = as_global(ap->in[20]), *p4 = as_global(ap->in[21]); \
          asm volatile("" : "+v"(tid), "+s"(G), "+s"(bid)); \
          C.lds = (LAS unsigned char*)lds; C.tid = tid; C.lane = tid & 63; C.wave = __builtin_amdgcn_readfirstlane(tid >> 6); C.G = G; C.bid = bid; \
          C.gw = bid * NWAVES + C.wave; C.NGW = G * NWAVES; C.rel_bias = p0; C.q_norm = p1; C.k_norm = p2; C.ln_g = p3; C.ln_b = p4; C.out = out; C.ws = ws; }
    for (int s = 1; s < NSTEP; ++s) {
        int g0 = G_NONE, g1 = G_NONE, ln = -1;
        switch (s) {
        case 1: g0 = G_KV; break;
        case 2: g0 = G_ABIN; break;
        case 4: g0 = G_F0P; g1 = G_F0S; break;
        case 5: g0 = G_S1; g1 = G_DENSE; break;
        case 6: g0 = G_S2; break;
        case 7: g0 = G_ABOUT; break;
        case 8: ln = 0; g0 = G_GT0; g1 = G_UT0; break;
        case 9: g0 = G_XSP0; g1 = G_XSS0; break;
        case 10: g0 = G_XOP0; g1 = G_XOS0; break;
        case 11: ln = 1; break;
        case 12: g0 = G_FIN0; break;
        case 13: g0 = G_FOUT0; break;
        case 14: ln = 2; break;
        case 15: g0 = G_CDIN; break;
        case 17: g0 = G_POOL; break;
        case 18: g0 = G_CDOUT; break;
        case 19: ln = 3; g0 = G_GT1; g1 = G_UT1; break;
        case 20: g0 = G_XSP1; g1 = G_XSS1; break;
        case 21: g0 = G_XOP1; g1 = G_XOS1; break;
        case 22: ln = 4; break;
        case 23: g0 = G_FIN1; break;
        case 24: g0 = G_FOUT1; break;
        case 25: ln = 5; break;
        default: break;
        }
        if (s == 3) { MK_CTX(C); dil_phase(C); gln_pass(C); }
        if (s == 16) { MK_CTX(C); rope_pass(C); pool_pass(C); }
        if (ln >= 0) { MK_CTX(C); ln_pass(C, ln); }
        for (int k = 0; k < 2; ++k) {
            const int id = k == 0 ? g0 : g1; if (id < 0) continue;
            int G = gridDim.x, bid = blockIdx.x; cargs_t ap = AR; asm volatile("" : "+s"(ap), "+s"(G), "+s"(bid));
            const pg8::cgd_t d = (pg8::cgd_t)(uintptr_t)((GD*)(ap->ws + WS_DESC) + id);
            pg8::GenSched S; S.d = d; S.G = G; S.c = bid;
            const pg8::Gemm g{d->K, d->lda, d->ldb, d->hA, d->hB};
            const int kind = d->kind;
            LAS unsigned char* ring = (LAS unsigned char*)lds; LAS unsigned char* xl = ring + XLDS_OFF;
            if (kind == K_BF16) { pg8::EpiBf16 E{d}; pg8::gemm_phase<pg8::EpiBf16, pg8::GenSched, true, true>(ring, xl, g, S, E); }
            else if (kind == K_SWIGLU) { pg8::EpiSwiglu E{d}; pg8::gemm_phase<pg8::EpiSwiglu, pg8::GenSched, true, true>(ring, xl, g, S, E); }
            else if (kind == K_RESID) { pg8::EpiResid E{d, DN_ALPHA}; pg8::gemm_phase<pg8::EpiResid, pg8::GenSched, true, true>(ring, xl, g, S, E); }
            else if (kind == K_SOFTMAX) { pg8::EpiSoftmax E{d}; pg8::gemm_phase<pg8::EpiSoftmax, pg8::GenSched, true, true>(ring, xl, g, S, E); }
            else { pg8::EpiTwiddle E{d}; pg8::gemm_phase<pg8::EpiTwiddle, pg8::GenSched, true, true>(ring, xl, g, S, E); }
        }
        if (s == 17) { MK_CTX(C); gqa_phase(C, (char*)lds); }
        if (s + 1 < NSTEP) grid.sync();
    }
}

extern "C" void kernel_launch(void* const* d_in, const int* in_sizes, int n_in, void* d_out, int out_size, void* d_ws, size_t ws_size, hipStream_t stream) {
    static int grid = 0;
    if (grid == 0) {
        if (n_in != 22 || ws_size < WS_END) { fprintf(stderr, "kernel_launch: unexpected n_in %d / ws %zu\n", n_in, ws_size); grid = -1; return; }
        int dev = 0, cus = 0, per_cu = 0;
        (void)hipGetDevice(&dev); (void)hipDeviceGetAttribute(&cus, hipDeviceAttributeMultiprocessorCount, dev);
        (void)hipFuncSetAttribute((const void*)mega_fwd, hipFuncAttributeMaxDynamicSharedMemorySize, LDS_BYTES);
        (void)hipOccupancyMaxActiveBlocksPerMultiprocessor(&per_cu, (const void*)mega_fwd, NTHR, LDS_BYTES);
        (void)hipGetLastError();
        grid = cus;
    }
    if (grid < 0) return;
    Args a{};
    for (int i = 0; i < 22; ++i) a.in[i] = (const float*)d_in[i];
    a.out = (float*)d_out; a.ws = (unsigned char*)d_ws;
    void* params[] = {&a};
    hipError_t e = hipLaunchCooperativeKernel((const void*)mega_fwd, dim3(grid), dim3(NTHR), params, LDS_BYTES, stream);
    if (e != hipSuccess) fprintf(stderr, "cooperative launch failed: %s (grid %d)\n", hipGetErrorString(e), grid);
}
```
